# Optimizing an MI355X kernel written in HIP

```python
import math
import jax, jax.numpy as jnp
from jax import lax
import numpy as np

D_MODEL = 1024
BATCH = 16
SEQ = 2048
DEPTH = 4

D_MIX = D_MODEL
D_ATTN = D_MIX // 2
D_REC = D_MIX - D_ATTN
HEAD_DIM = 64
N_ATTN_HEADS = D_ATTN // HEAD_DIM
N_REC_BLOCKS = 8
REC_BLOCK = D_REC // N_REC_BLOCKS
CONV_WIDTH = 4
LRU_C = 8.0
DILATED_PATTERNS = ((128, 1), (512, 4), (2048, 16))
ROPE_THETA = 10000.0
D_FF = 256 * ((8 * D_MODEL // 3 + 255) // 256)
D_IN_PROJ = 3 * D_ATTN + 2 * D_REC
EPS = 1e-6

kernel_name = "hymba_rglru_dilated_attn_macaron"


def rms_norm(x, g):
    xf = x.astype(jnp.float32)
    var = jnp.mean(xf * xf, axis=-1, keepdims=True)
    return (xf * lax.rsqrt(var + EPS) * g.astype(jnp.float32)).astype(x.dtype)


def swiglu_ffn(x, g, w_in, w_out):
    h = rms_norm(x, g) @ w_in
    gate, up = jnp.split(h, 2, axis=-1)
    return (jax.nn.silu(gate) * up) @ w_out


def rope_tables(seq):
    pos = jnp.arange(seq, dtype=jnp.float32)
    inv = ROPE_THETA ** (-jnp.arange(0, HEAD_DIM, 2, dtype=jnp.float32) / HEAD_DIM)
    ang = pos[:, None] * inv[None, :]
    return jnp.cos(ang), jnp.sin(ang)


def apply_rope(t, cos, sin):
    tf = t.astype(jnp.float32)
    half = HEAD_DIM // 2
    t1, t2 = tf[..., :half], tf[..., half:]
    c = cos[None, :, None, :]
    s = sin[None, :, None, :]
    return jnp.concatenate([t1 * c - t2 * s, t2 * c + t1 * s], axis=-1)


def dilated_band_attention(q, k, v, window, dilation):
    B, S, H, Dh = q.shape
    steps = window // dilation
    L = S // dilation
    nb = -(-L // steps)
    Lp = nb * steps

    def to_classes(t):
        return t.reshape(B, L, dilation, H, Dh).transpose(0, 2, 3, 1, 4)

    qc, kc, vc = to_classes(q), to_classes(k), to_classes(v)
    qc = jnp.pad(qc, ((0, 0), (0, 0), (0, 0), (0, Lp - L), (0, 0)))
    kc = jnp.pad(kc, ((0, 0), (0, 0), (0, 0), (steps, Lp - L), (0, 0)))
    vc = jnp.pad(vc, ((0, 0), (0, 0), (0, 0), (steps, Lp - L), (0, 0)))

    def band_keys(t):
        prev = t[:, :, :, :Lp].reshape(B, dilation, H, nb, steps, Dh)
        cur = t[:, :, :, steps:].reshape(B, dilation, H, nb, steps, Dh)
        return jnp.concatenate([prev, cur], axis=-2)

    q_blk = qc.reshape(B, dilation, H, nb, steps, Dh)
    k_blk, v_blk = band_keys(kc), band_keys(vc)

    scores = jnp.einsum('bdhnqc,bdhnkc->bdhnqk', q_blk, k_blk,
                        preferred_element_type=jnp.float32) / math.sqrt(Dh)
    qi = jnp.arange(steps)[:, None]
    kj = jnp.arange(2 * steps)[None, :]
    dist = qi + steps - kj
    key_idx = jnp.arange(nb)[:, None, None] * steps - steps + kj[None]
    valid = (dist >= 0)[None] & (dist <= steps)[None] & (key_idx >= 0)
    scores = jnp.where(valid, scores, -jnp.inf)
    m = jnp.max(scores, axis=-1, keepdims=True)
    p = jnp.exp(scores - m)
    s = jnp.sum(p, axis=-1, keepdims=True)
    num = jnp.einsum('bdhnqk,bdhnkc->bdhnqc', p, v_blk.astype(jnp.float32))

    def from_classes(t):
        c = t.shape[-1]
        t = t.reshape(B, dilation, H, Lp, c)[:, :, :, :L]
        return t.transpose(0, 3, 1, 2, 4).reshape(B, S, H, c)

    return from_classes(num), from_classes(m), from_classes(s)


def dilated_attention_group(q, k, v):
    nums, ms, ss = [], [], []
    for window, dilation in DILATED_PATTERNS:
        n_, m_, s_ = dilated_band_attention(q, k, v, window, dilation)
        nums.append(n_); ms.append(m_); ss.append(s_)
    m_all = jnp.maximum(jnp.maximum(ms[0], ms[1]), ms[2])
    ws = [jnp.exp(m_ - m_all) for m_ in ms]
    numer = nums[0] * ws[0] + nums[1] * ws[1] + nums[2] * ws[2]
    denom = ss[0] * ws[0] + ss[1] * ws[1] + ss[2] * ws[2]
    return numer / denom


def causal_depthwise_conv(x, w, b):
    C = x.shape[-1]
    out = lax.conv_general_dilated(
        x, w[:, None, :].astype(x.dtype), window_strides=(1,),
        padding=[(CONV_WIDTH - 1, 0)], dimension_numbers=('NWC', 'WIO', 'NWC'),
        feature_group_count=C)
    return out + b


def block_diag_linear(x, w, b):
    B, S, _ = x.shape
    xb = x.reshape(B, S, N_REC_BLOCKS, REC_BLOCK)
    return jnp.einsum('bsgi,gij->bsgj', xb, w).reshape(B, S, D_REC) + b


def rglru_group(xb, gb, conv_w, conv_b, w_a, b_a, w_x, b_x, lam):
    xr = causal_depthwise_conv(xb, conv_w, conv_b).astype(jnp.float32)
    r = jax.nn.sigmoid(block_diag_linear(xr, w_a.astype(jnp.float32), b_a.astype(jnp.float32)))
    i = jax.nn.sigmoid(block_diag_linear(xr, w_x.astype(jnp.float32), b_x.astype(jnp.float32)))
    log_a = -LRU_C * r * jax.nn.softplus(-lam.astype(jnp.float32))
    a = jnp.exp(log_a)
    u = jnp.sqrt(-jnp.expm1(2.0 * log_a)) * (i * xr)

    def combine(c1, c2):
        a1, b1 = c1
        a2, b2 = c2
        return a1 * a2, a2 * b1 + b2

    _, h = lax.associative_scan(combine, (a, u), axis=1)
    return h * jax.nn.gelu(gb.astype(jnp.float32))


def hybrid_mixer(x, norm_g, w_in, conv_w, conv_b, w_a, b_a, w_x, b_x, lam,
                 attn_out_g, rec_out_g, w_out, cos, sin):
    B, S, _ = x.shape
    h = rms_norm(x, norm_g)
    proj = h @ w_in
    q, k, v, xb, gb = jnp.split(
        proj, [D_ATTN, 2 * D_ATTN, 3 * D_ATTN, 3 * D_ATTN + D_REC], axis=-1)
    q = apply_rope(q.reshape(B, S, N_ATTN_HEADS, HEAD_DIM), cos, sin)
    k = apply_rope(k.reshape(B, S, N_ATTN_HEADS, HEAD_DIM), cos, sin)
    v = v.reshape(B, S, N_ATTN_HEADS, HEAD_DIM).astype(jnp.float32)
    y_attn = dilated_attention_group(q, k, v).reshape(B, S, D_ATTN)
    y_rec = rglru_group(xb, gb, conv_w, conv_b, w_a, b_a, w_x, b_x, lam)
    merged = jnp.concatenate(
        [rms_norm(y_attn, attn_out_g), rms_norm(y_rec, rec_out_g)], axis=-1).astype(x.dtype)
    return merged @ w_out


def setup_inputs(seed: int = 0) -> dict:
    key = jax.random.key(seed)
    ks = jax.random.split(key, 20)
    L = DEPTH

    def nrm(k, shape, scale):
        return jax.random.normal(k, shape, jnp.float32) * scale

    def gain(k, shape):
        return 1.0 + 0.02 * jax.random.normal(k, shape, jnp.float32)

    a0 = jax.random.uniform(ks[12], (L, D_REC), jnp.float32, minval=0.9, maxval=0.999)
    return {
        "x": nrm(ks[0], (BATCH, SEQ, D_MODEL), 1.0),
        "ffn1_norm": gain(ks[1], (L, D_MODEL)),
        "ffn1_w_in": nrm(ks[2], (L, D_MODEL, 2 * D_FF), D_MODEL ** -0.5),
        "ffn1_w_out": nrm(ks[3], (L, D_FF, D_MODEL), D_FF ** -0.5),
        "mix_norm": gain(ks[4], (L, D_MODEL)),
        "w_in": nrm(ks[5], (L, D_MODEL, D_IN_PROJ), D_MODEL ** -0.5),
        "conv_w": nrm(ks[6], (L, CONV_WIDTH, D_REC), CONV_WIDTH ** -0.5),
        "conv_b": nrm(ks[7], (L, D_REC), 0.01),
        "rg_w_a": nrm(ks[8], (L, N_REC_BLOCKS, REC_BLOCK, REC_BLOCK), REC_BLOCK ** -0.5),
        "rg_b_a": nrm(ks[9], (L, D_REC), 0.01),
        "rg_w_x": nrm(ks[10], (L, N_REC_BLOCKS, REC_BLOCK, REC_BLOCK), REC_BLOCK ** -0.5),
        "rg_b_x": nrm(ks[11], (L, D_REC), 0.01),
        "rg_lambda": jnp.log(a0) - jnp.log1p(-a0),
        "attn_out_norm": gain(ks[13], (L, D_ATTN)),
        "rec_out_norm": gain(ks[14], (L, D_REC)),
        "w_out": nrm(ks[15], (L, D_MIX, D_MODEL), D_MIX ** -0.5),
        "ffn2_norm": gain(ks[16], (L, D_MODEL)),
        "ffn2_w_in": nrm(ks[17], (L, D_MODEL, 2 * D_FF), D_MODEL ** -0.5),
        "ffn2_w_out": nrm(ks[18], (L, D_FF, D_MODEL), D_FF ** -0.5),
        "final_norm": gain(ks[19], (D_MODEL,)),
    }


def reference(x, ffn1_norm, ffn1_w_in, ffn1_w_out, mix_norm, w_in, conv_w, conv_b,
              rg_w_a, rg_b_a, rg_w_x, rg_b_x, rg_lambda, attn_out_norm, rec_out_norm,
              w_out, ffn2_norm, ffn2_w_in, ffn2_w_out, final_norm):
    cos, sin = rope_tables(x.shape[1])
    for l in range(DEPTH):
        x = x + 0.5 * swiglu_ffn(x, ffn1_norm[l], ffn1_w_in[l], ffn1_w_out[l])
        x = x + hybrid_mixer(x, mix_norm[l], w_in[l], conv_w[l], conv_b[l],
                             rg_w_a[l], rg_b_a[l], rg_w_x[l], rg_b_x[l], rg_lambda[l],
                             attn_out_norm[l], rec_out_norm[l], w_out[l], cos, sin)
        x = x + 0.5 * swiglu_ffn(x, ffn2_norm[l], ffn2_w_in[l], ffn2_w_out[l])
    return rms_norm(x, final_norm)
```

```cpp
#include <hip/hip_runtime.h>
#include <hip/hip_cooperative_groups.h>
#include <cstdio>
#include <cstdint>
#include <cmath>
namespace cg = cooperative_groups;
namespace pg8 {
#define PG8_LAS __attribute__((address_space(3)))
typedef unsigned short bf16_t;
typedef short bf16x8 __attribute__((ext_vector_type(8)));
typedef float f32x4 __attribute__((ext_vector_type(4)));
typedef unsigned u32x4 __attribute__((ext_vector_type(4)));
constexpr int BM = 256, BK = 64, HALF = 128, HTB = HALF * BK * 2  , STAGE_BYTES = 8 * HTB, NXCD = 8, WGM = 8;

__host__ __device__ __forceinline__ int lds_byte(int r, int c) { const int st = (r >> 4) * 2 + (c >> 5), rr = r & 15, cc = c & 31, ob = rr * 64 + cc * 2; return st * 1024 + (ob ^ (((ob >> 9) & 1) << 5)); }
__host__ __device__ __forceinline__ void stage_rc(int b, int& R, int& C) { const int st = b / 1024, sb = b % 1024, swz = sb ^ (((sb >> 9) & 1) << 5); R = (st >> 1) * 16 + swz / 64; C = (st & 1) * 32 + (swz % 64) / 2; }
__host__ __device__ __forceinline__ int perm32(int rho) { const int n = rho >> 4, i = rho & 15; return 8 * (i >> 2) + 4 * n + (i & 3); }

struct Unit { int pm, pn; };
struct Gemm { const bf16_t* A; const bf16_t* Bt; int M, N, K; };

struct StaticOrder {
    int nM, nN, nwg, G, c;
    __host__ __device__ void init(int M, int N, int G_, int c_) { nM = M / BM; nN = N / BM; nwg = nM * nN; G = G_; c = c_; }
    __host__ __device__ bool next(int i, Unit& u) const {
        const long L = (long)i * G + c; if (L >= nwg) return false;
        int wgid = (int)L; { const int q = nwg / NXCD, r = nwg % NXCD, xcd = wgid % NXCD, off = wgid / NXCD; wgid = (xcd < r ? xcd * (q + 1) : r * (q + 1) + (xcd - r) * q) + off; }
        const int nig = WGM * nN, gid = wgid / nig, fm = gid * WGM, gsz = (nM - fm) < WGM ? (nM - fm) : WGM;
        u.pm = fm + ((wgid % nig) % gsz); u.pn = (wgid % nig) / gsz; return true;
    }
    __device__ __forceinline__ void a_ready(const Unit&, int) const {}
    __device__ __forceinline__ void a_ready_inloop(const Unit&, int) const {}
    struct Pre {}; __device__ __forceinline__ void issue(const Unit&, Pre&) const {} __device__ __forceinline__ void commit(const Unit&, int, const Pre&) const {}
    __device__ __forceinline__ void done(const Unit&) const {}
};

__device__ __forceinline__ unsigned cvt_pk_bf16(float lo, float hi) { unsigned r; asm volatile("v_cvt_pk_bf16_f32 %0, %1, %2" : "=v"(r) : "v"(lo), "v"(hi)); return r; }
typedef float f32x2 __attribute__((ext_vector_type(2)));
__device__ __forceinline__ f32x2 gelu_pk(f32x2 v) {
    const f32x2 av = __builtin_elementwise_abs(v), d = av * 0.2316418882f + 1.0f;
    f32x2 t; t.x = __builtin_amdgcn_rcpf(d.x); t.y = __builtin_amdgcn_rcpf(d.y);
    f32x2 q = t * 0.5307027145f + (-0.7265760135f); q = q * t + 0.7107068705f; q = q * t + (-0.142248368f); q = q * t + 0.127414796f; q = q * t;
    const f32x2 s = (v * v) * (-0.72134752044f);
    f32x2 e; e.x = __builtin_amdgcn_exp2f(s.x); e.y = __builtin_amdgcn_exp2f(s.y);
    const f32x2 m = v * (q * e), r = v - m;
    f32x2 o; o.x = v.x < 0.f ? m.x : r.x; o.y = v.y < 0.f ? m.y : r.y; return o;
}

template <int ACT  > struct EpiBf16 {
    static constexpr bool PERM = true, AFTER_DRAIN = false; static constexpr int MID_T = -1; static_assert(ACT == 0 || ACT == 1, "EpiBf16: ACT is 0 (none) or 1 (gelu_pk)");
    bf16_t* O; int ldc; const float* bias; int split_cols; size_t split_stride; float scale0;
    __device__ __forceinline__ void operator()(const f32x4 (&acc)[2][2][4][2], const Unit& u, int ui, int wr, int wc, int fr, int fq) const {
        const int row0 = u.pm * BM + wr * 64 + fr; int colt = u.pn * BM; bf16_t* base = O;
        float sc = 1.f; if (split_cols) { const int t = colt / split_cols; base += (size_t)t * split_stride; colt -= t * split_cols; if (t == 0) sc = scale0; }
        const int col0 = colt + wc * 32 + 8 * fq, bcol0 = u.pn * BM + wc * 32 + 8 * fq;
        f32x4 bv[2][2];
#pragma unroll
        for (int bj = 0; bj < 2; ++bj)
#pragma unroll
            for (int n = 0; n < 2; ++n) bv[bj][n] = bias ? *(const f32x4*)(bias + bcol0 + bj * HALF + 4 * n) : (f32x4){0.f, 0.f, 0.f, 0.f};
#pragma unroll
        for (int ai = 0; ai < 2; ++ai)
#pragma unroll
            for (int m = 0; m < 4; ++m) { bf16_t* rowp = base + (size_t)(row0 + ai * HALF + m * 16) * ldc + col0;
#pragma unroll
                for (int bj = 0; bj < 2; ++bj) { f32x4 v0 = acc[ai][bj][m][0] + bv[bj][0], v1 = acc[ai][bj][m][1] + bv[bj][1];
                    if (ACT == 1) { f32x2 a = gelu_pk((f32x2){v0[0], v0[1]}), b = gelu_pk((f32x2){v0[2], v0[3]}), c = gelu_pk((f32x2){v1[0], v1[1]}), d = gelu_pk((f32x2){v1[2], v1[3]});
                        v0 = (f32x4){a.x, a.y, b.x, b.y}; v1 = (f32x4){c.x, c.y, d.x, d.y}; }
                    v0 = v0 * sc; v1 = v1 * sc; u32x4 w; w.x = cvt_pk_bf16(v0[0], v0[1]); w.y = cvt_pk_bf16(v0[2], v0[3]); w.z = cvt_pk_bf16(v1[0], v1[1]); w.w = cvt_pk_bf16(v1[2], v1[3]);
                    *(u32x4*)(rowp + bj * HALF) = w; } }
    }
};
__device__ __forceinline__ float xsum_fq(float s) {
    s += __uint_as_float((unsigned)__builtin_amdgcn_ds_swizzle((int)__float_as_uint(s), 0x401F));
    auto rr = __builtin_amdgcn_permlane32_swap(__float_as_uint(s), __float_as_uint(s), false, false);
    return __uint_as_float(rr[0]) + __uint_as_float(rr[1]);
}
__device__ __forceinline__ float row_rs(const float* ssq, int row) {
    typedef const __attribute__((address_space(1))) f32x4* gp_t; gp_t p = (gp_t)(ssq + (size_t)row * 16); const f32x4 a = p[0], b = p[1], c = p[2], d = p[3];
    const float s = (((a[0] + a[1]) + (a[2] + a[3])) + ((b[0] + b[1]) + (b[2] + b[3]))) + (((c[0] + c[1]) + (c[2] + c[3])) + ((d[0] + d[1]) + (d[2] + d[3])));
    return 1.0f / sqrtf(s * (1.0f / 1024.0f) + 1e-6f);
}
struct RsOrder : StaticOrder {
    const float* ssq; PG8_LAS float* rsb;
    typedef const __attribute__((address_space(1))) f32x4* gp_t;
    struct Pre { f32x4 a, b, c, d; };
    static __device__ __forceinline__ float fin(const f32x4& a, const f32x4& b, const f32x4& c, const f32x4& d) {
        const float s = (((a[0] + a[1]) + (a[2] + a[3])) + ((b[0] + b[1]) + (b[2] + b[3]))) + (((c[0] + c[1]) + (c[2] + c[3])) + ((d[0] + d[1]) + (d[2] + d[3])));
        return 1.0f / sqrtf(s * (1.0f / 1024.0f) + 1e-6f); }
    __device__ __forceinline__ void issue(const Unit& u, Pre& p) const {
        int t = threadIdx.x; asm volatile("" : "+v"(t));
        if (t < 256) { gp_t g = (gp_t)(ssq + (size_t)(u.pm * BM + t) * 16); p.a = g[0]; p.b = g[1]; p.c = g[2]; p.d = g[3]; }
    }
    __device__ __forceinline__ void commit(const Unit& u, int ui, const Pre& p) const {
        int t = threadIdx.x; asm volatile("" : "+v"(t));
        if (t < 256) rsb[(ui & 1) * 256 + t] = fin(p.a, p.b, p.c, p.d);
    }
    __device__ __forceinline__ void a_ready(const Unit& u, int ui) const { Pre p; issue(u, p); commit(u, ui, p); }
};
__device__ __forceinline__ float silu_f(float g) { return g * __builtin_amdgcn_rcpf(1.0f + __expf(-g)); }
struct EpiSwiGLU {
    static constexpr bool PERM = true, AFTER_DRAIN = false; static constexpr int MID_T = -1;
    bf16_t* H; int ldh; const PG8_LAS float* rsb;
    __device__ __forceinline__ void operator()(const f32x4 (&acc)[2][2][4][2], const Unit& u, int ui, int wr, int wc, int fr, int fq) const {
        const int row0 = u.pm * BM + wr * 64 + fr, col0 = u.pn * HALF + wc * 32 + 8 * fq;
#pragma unroll
        for (int ai = 0; ai < 2; ++ai)
#pragma unroll
            for (int m = 0; m < 4; ++m) {
                const int row = row0 + ai * HALF + m * 16;
                const float s = rsb[(ui & 1) * 256 + ai * HALF + wr * 64 + m * 16 + fr];
                f32x4 g0 = acc[ai][0][m][0] * s, g1 = acc[ai][0][m][1] * s, u0 = acc[ai][1][m][0] * s, u1 = acc[ai][1][m][1] * s;
                u32x4 w;
                w.x = cvt_pk_bf16(silu_f(g0[0]) * u0[0], silu_f(g0[1]) * u0[1]); w.y = cvt_pk_bf16(silu_f(g0[2]) * u0[2], silu_f(g0[3]) * u0[3]);
                w.z = cvt_pk_bf16(silu_f(g1[0]) * u1[0], silu_f(g1[1]) * u1[1]); w.w = cvt_pk_bf16(silu_f(g1[2]) * u1[2], silu_f(g1[3]) * u1[3]);
                *(u32x4*)(H + (size_t)row * ldh + col0) = w;
            }
    }
};
struct EpiResid {
    static constexpr bool PERM = true, AFTER_DRAIN = false; static constexpr int MID_T = -1;
    const float* base; float* out; int ldc; float scale;
    __device__ __forceinline__ void operator()(const f32x4 (&acc)[2][2][4][2], const Unit& u, int ui, int wr, int wc, int fr, int fq) const {
        const int row0 = u.pm * BM + wr * 64 + fr, col0 = u.pn * BM + wc * 32 + 8 * fq;
#pragma unroll
        for (int ai = 0; ai < 2; ++ai)
#pragma unroll
            for (int m = 0; m < 4; ++m) {
                const size_t off = (size_t)(row0 + ai * HALF + m * 16) * ldc + col0;
#pragma unroll
                for (int bj = 0; bj < 2; ++bj) {
                    const f32x4 b0 = *(const f32x4*)(base + off + bj * HALF), b1 = *(const f32x4*)(base + off + bj * HALF + 4);
                    *(f32x4*)(out + off + bj * HALF) = b0 + acc[ai][bj][m][0] * scale;
                    *(f32x4*)(out + off + bj * HALF + 4) = b1 + acc[ai][bj][m][1] * scale;
                }
            }
    }
};

struct EpiResid2 {
    static constexpr bool PERM = true, AFTER_DRAIN = false; static constexpr int MID_T = -1;
    const float* base; float* out; bf16_t* xb; float* ssq; int ldc; float scale;
    __device__ __forceinline__ void operator()(const f32x4 (&acc)[2][2][4][2], const Unit& u, int ui, int wr, int wc, int fr, int fq) const {
        const int row0 = u.pm * BM + wr * 64 + fr, col0 = u.pn * BM + wc * 32 + 8 * fq;
#pragma unroll
        for (int ai = 0; ai < 2; ++ai) {
            f32x4 bs[4][2][2];
#pragma unroll
            for (int m = 0; m < 4; ++m) { const size_t off = (size_t)(row0 + ai * HALF + m * 16) * ldc + col0;
#pragma unroll
                for (int bj = 0; bj < 2; ++bj) { bs[m][bj][0] = *(const f32x4*)(base + off + bj * HALF); bs[m][bj][1] = *(const f32x4*)(base + off + bj * HALF + 4); } }
#pragma unroll
            for (int m = 0; m < 4; ++m) {
                const int row = row0 + ai * HALF + m * 16;
                const size_t off = (size_t)row * ldc + col0;
                float s = 0.f;
#pragma unroll
                for (int bj = 0; bj < 2; ++bj) {
                    const f32x4 o0 = bs[m][bj][0] + acc[ai][bj][m][0] * scale, o1 = bs[m][bj][1] + acc[ai][bj][m][1] * scale;
                    *(f32x4*)(out + off + bj * HALF) = o0; *(f32x4*)(out + off + bj * HALF + 4) = o1;
                    s += ((o0[0] * o0[0] + o0[1] * o0[1]) + (o0[2] * o0[2] + o0[3] * o0[3])) + ((o1[0] * o1[0] + o1[1] * o1[1]) + (o1[2] * o1[2] + o1[3] * o1[3]));
                    u32x4 w; w.x = cvt_pk_bf16(o0[0], o0[1]); w.y = cvt_pk_bf16(o0[2], o0[3]); w.z = cvt_pk_bf16(o1[0], o1[1]); w.w = cvt_pk_bf16(o1[2], o1[3]);
                    *(u32x4*)(xb + off + bj * HALF) = w;
                }
                s = xsum_fq(s);
                if (fq == 0) ssq[(size_t)row * 16 + u.pn * 4 + wc] = s;
            }
        }
    }
};
struct EpiProj {
    static constexpr bool PERM = true, AFTER_DRAIN = false; static constexpr int MID_T = -1;
    bf16_t* P; int ldp; const PG8_LAS float* rsb; const float* rc; const float* rsn;
    __device__ __forceinline__ void operator()(const f32x4 (&acc)[2][2][4][2], const Unit& u, int ui, int wr, int wc, int fr, int fq) const {
        typedef unsigned u32x2v __attribute__((ext_vector_type(2)));
        const int row0 = u.pm * BM + wr * 64 + fr;
        if (u.pn < 4) {
            const int dl = 16 * (wc & 1) + 4 * fq;
#pragma unroll
            for (int ai = 0; ai < 2; ++ai) {
                f32x4 cs[2][4], sn[2][4];
#pragma unroll
                for (int m = 0; m < 4; ++m) { const int t = (row0 + ai * HALF + m * 16) & 2047; cs[ai][m] = *(const f32x4*)(rc + t * 32 + dl); sn[ai][m] = *(const f32x4*)(rsn + t * 32 + dl); }
#pragma unroll
                for (int m = 0; m < 4; ++m) {
                    const int row = row0 + ai * HALF + m * 16;
                    const float r = rsb[(ui & 1) * 256 + ai * HALF + wr * 64 + m * 16 + fr];
                    bf16_t* prow = P + (size_t)row * ldp + u.pn * BM;
                    const float qs = (u.pn < 2) ? (r * 0.18033688011112042f) : r;
#pragma unroll
                    for (int bj = 0; bj < 2; ++bj) {
                        const f32x4 a = acc[ai][bj][m][0] * qs, b = acc[ai][bj][m][1] * qs;
                        const f32x4 lo = a * cs[ai][m] - b * sn[ai][m], hi = b * cs[ai][m] + a * sn[ai][m];
                        bf16_t* hp = prow + bj * HALF + 64 * (wc >> 1) + dl;
                        u32x2v wl, wh; wl.x = cvt_pk_bf16(lo[0], lo[1]); wl.y = cvt_pk_bf16(lo[2], lo[3]); wh.x = cvt_pk_bf16(hi[0], hi[1]); wh.y = cvt_pk_bf16(hi[2], hi[3]);
                        *(u32x2v*)hp = wl; *(u32x2v*)(hp + 32) = wh;
                    }
                }
            }
        } else {
#pragma unroll
            for (int ai = 0; ai < 2; ++ai)
#pragma unroll
                for (int m = 0; m < 4; ++m) {
                    const int row = row0 + ai * HALF + m * 16;
                    const float r = rsb[(ui & 1) * 256 + ai * HALF + wr * 64 + m * 16 + fr];
                    bf16_t* prow = P + (size_t)row * ldp + u.pn * BM;
#pragma unroll
                    for (int bj = 0; bj < 2; ++bj) {
                        const f32x4 v0 = acc[ai][bj][m][0] * r, v1 = acc[ai][bj][m][1] * r;
                        u32x4 w; w.x = cvt_pk_bf16(v0[0], v0[1]); w.y = cvt_pk_bf16(v0[2], v0[3]); w.z = cvt_pk_bf16(v1[0], v1[1]); w.w = cvt_pk_bf16(v1[2], v1[3]);
                        *(u32x4*)(prow + bj * HALF + wc * 32 + 8 * fq) = w;
                    }
                }
        }
    }
};

struct MixOrder : StaticOrder {
    const float* ssqa; const float* ssqr; PG8_LAS float* rsb;
    typedef const __attribute__((address_space(1))) f32x4* gp_t;
    struct Pre { f32x4 a0, a1, r0, r1, r2, r3; };
    __device__ __forceinline__ void issue(const Unit& u, Pre& p) const {
        int t = threadIdx.x; asm volatile("" : "+v"(t));
        if (t < 256) { const int row = u.pm * BM + t; gp_t pa = (gp_t)(ssqa + (size_t)row * 8), pr = (gp_t)(ssqr + (size_t)row * 16);
            p.a0 = pa[0]; p.a1 = pa[1]; p.r0 = pr[0]; p.r1 = pr[1]; p.r2 = pr[2]; p.r3 = pr[3]; }
    }
    __device__ __forceinline__ void commit(const Unit& u, int ui, const Pre& p) const {
        int t = threadIdx.x; asm volatile("" : "+v"(t));
        if (t < 256) {
            const float sa = ((p.a0[0] + p.a0[1]) + (p.a0[2] + p.a0[3])) + ((p.a1[0] + p.a1[1]) + (p.a1[2] + p.a1[3]));
            const float sr = (((p.r0[0] + p.r0[1]) + (p.r0[2] + p.r0[3])) + ((p.r1[0] + p.r1[1]) + (p.r1[2] + p.r1[3]))) + (((p.r2[0] + p.r2[1]) + (p.r2[2] + p.r2[3])) + ((p.r3[0] + p.r3[1]) + (p.r3[2] + p.r3[3])));
            const float ra = 1.0f / sqrtf(sa * (1.0f / 512.0f) + 1e-6f), rr = 1.0f / sqrtf(sr * (1.0f / 512.0f) + 1e-6f);
            rsb[(ui & 1) * 256 + t] = rr; rsb[512 + (ui & 1) * 256 + t] = ra / rr;
        }
    }
    __device__ __forceinline__ void a_ready(const Unit& u, int ui) const { Pre p; issue(u, p); commit(u, ui, p); }
};
struct EpiResidMix {
    static constexpr bool PERM = true, AFTER_DRAIN = false; static constexpr int MID_T = 8;
    const float* base; float* out; bf16_t* xb; float* ssq; int ldc; const PG8_LAS float* rsb;
    __device__ __forceinline__ void mid(f32x4 (&acc)[2][2][4][2], int ui, int wr, int fr) const {
#pragma unroll
        for (int ai = 0; ai < 2; ++ai)
#pragma unroll
            for (int m = 0; m < 4; ++m) { const float q = rsb[512 + (ui & 1) * 256 + ai * HALF + wr * 64 + m * 16 + fr];
#pragma unroll
                for (int bj = 0; bj < 2; ++bj) { acc[ai][bj][m][0] *= q; acc[ai][bj][m][1] *= q; } }
    }
    __device__ __forceinline__ void operator()(const f32x4 (&acc)[2][2][4][2], const Unit& u, int ui, int wr, int wc, int fr, int fq) const {
        const int row0 = u.pm * BM + wr * 64 + fr, col0 = u.pn * BM + wc * 32 + 8 * fq;
#pragma unroll
        for (int ai = 0; ai < 2; ++ai) {
            f32x4 bs[4][2][2];
#pragma unroll
            for (int m = 0; m < 4; ++m) { const size_t off = (size_t)(row0 + ai * HALF + m * 16) * ldc + col0;
#pragma unroll
                for (int bj = 0; bj < 2; ++bj) { bs[m][bj][0] = *(const f32x4*)(base + off + bj * HALF); bs[m][bj][1] = *(const f32x4*)(base + off + bj * HALF + 4); } }
#pragma unroll
            for (int m = 0; m < 4; ++m) {
                const int row = row0 + ai * HALF + m * 16;
                const size_t off = (size_t)row * ldc + col0;
                const float scale = rsb[(ui & 1) * 256 + ai * HALF + wr * 64 + m * 16 + fr];
                float s = 0.f;
#pragma unroll
                for (int bj = 0; bj < 2; ++bj) {
                    const f32x4 o0 = bs[m][bj][0] + acc[ai][bj][m][0] * scale, o1 = bs[m][bj][1] + acc[ai][bj][m][1] * scale;
                    *(f32x4*)(out + off + bj * HALF) = o0; *(f32x4*)(out + off + bj * HALF + 4) = o1;
                    s += ((o0[0] * o0[0] + o0[1] * o0[1]) + (o0[2] * o0[2] + o0[3] * o0[3])) + ((o1[0] * o1[0] + o1[1] * o1[1]) + (o1[2] * o1[2] + o1[3] * o1[3]));
                    u32x4 w; w.x = cvt_pk_bf16(o0[0], o0[1]); w.y = cvt_pk_bf16(o0[2], o0[3]); w.z = cvt_pk_bf16(o1[0], o1[1]); w.w = cvt_pk_bf16(o1[2], o1[3]);
                    *(u32x4*)(xb + off + bj * HALF) = w;
                }
                s = xsum_fq(s);
                if (fq == 0) ssq[(size_t)row * 16 + u.pn * 4 + wc] = s;
            }
        }
    }
};

__device__ __forceinline__ void resid_bf16_row(const f32x4& a0, const f32x4& a1, float scale, bf16_t* p, const u32x4 w, float& s) {
    f32x4 o0, o1;
    o0[0] = __uint_as_float(w.x << 16) + a0[0] * scale; o0[1] = __uint_as_float(w.x & 0xffff0000u) + a0[1] * scale; o0[2] = __uint_as_float(w.y << 16) + a0[2] * scale; o0[3] = __uint_as_float(w.y & 0xffff0000u) + a0[3] * scale;
    o1[0] = __uint_as_float(w.z << 16) + a1[0] * scale; o1[1] = __uint_as_float(w.z & 0xffff0000u) + a1[1] * scale; o1[2] = __uint_as_float(w.w << 16) + a1[2] * scale; o1[3] = __uint_as_float(w.w & 0xffff0000u) + a1[3] * scale;
    u32x4 r; r.x = cvt_pk_bf16(o0[0], o0[1]); r.y = cvt_pk_bf16(o0[2], o0[3]); r.z = cvt_pk_bf16(o1[0], o1[1]); r.w = cvt_pk_bf16(o1[2], o1[3]);
    *(u32x4*)p = r;
    const float q0 = __uint_as_float(r.x << 16), q1 = __uint_as_float(r.x & 0xffff0000u), q2 = __uint_as_float(r.y << 16), q3 = __uint_as_float(r.y & 0xffff0000u);
    const float q4 = __uint_as_float(r.z << 16), q5 = __uint_as_float(r.z & 0xffff0000u), q6 = __uint_as_float(r.w << 16), q7 = __uint_as_float(r.w & 0xffff0000u);
    s += ((q0 * q0 + q1 * q1) + (q2 * q2 + q3 * q3)) + ((q4 * q4 + q5 * q5) + (q6 * q6 + q7 * q7));
}
struct EpiResid2B {
    static constexpr bool PERM = true, AFTER_DRAIN = false; static constexpr int MID_T = -1;
    bf16_t* xb; float* ssq; int ldc; float scale;
    __device__ __forceinline__ void operator()(const f32x4 (&acc)[2][2][4][2], const Unit& u, int ui, int wr, int wc, int fr, int fq) const {
        const int row0 = u.pm * BM + wr * 64 + fr, col0 = u.pn * BM + wc * 32 + 8 * fq;
#pragma unroll
        for (int ai = 0; ai < 2; ++ai) {
            u32x4 old[4][2];
#pragma unroll
            for (int m = 0; m < 4; ++m) { const bf16_t* p = xb + (size_t)(row0 + ai * HALF + m * 16) * ldc + col0; old[m][0] = *(const u32x4*)p; old[m][1] = *(const u32x4*)(p + HALF); }
#pragma unroll
            for (int m = 0; m < 4; ++m) {
                const int row = row0 + ai * HALF + m * 16; bf16_t* p = xb + (size_t)row * ldc + col0; float s = 0.f;
                resid_bf16_row(acc[ai][0][m][0], acc[ai][0][m][1], scale, p, old[m][0], s); resid_bf16_row(acc[ai][1][m][0], acc[ai][1][m][1], scale, p + HALF, old[m][1], s);
                s = xsum_fq(s);
                if (fq == 0) ssq[(size_t)row * 16 + u.pn * 4 + wc] = s;
            }
        }
    }
};
struct EpiResidMixB {
    static constexpr bool PERM = true, AFTER_DRAIN = false; static constexpr int MID_T = 8;
    bf16_t* xb; float* ssq; int ldc; const PG8_LAS float* rsb;
    __device__ __forceinline__ void mid(f32x4 (&acc)[2][2][4][2], int ui, int wr, int fr) const {
#pragma unroll
        for (int ai = 0; ai < 2; ++ai)
#pragma unroll
            for (int m = 0; m < 4; ++m) { const float q = rsb[512 + (ui & 1) * 256 + ai * HALF + wr * 64 + m * 16 + fr];
#pragma unroll
                for (int bj = 0; bj < 2; ++bj) { acc[ai][bj][m][0] *= q; acc[ai][bj][m][1] *= q; } }
    }
    __device__ __forceinline__ void operator()(const f32x4 (&acc)[2][2][4][2], const Unit& u, int ui, int wr, int wc, int fr, int fq) const {
        const int row0 = u.pm * BM + wr * 64 + fr, col0 = u.pn * BM + wc * 32 + 8 * fq;
#pragma unroll
        for (int ai = 0; ai < 2; ++ai) {
            u32x4 old[4][2];
#pragma unroll
            for (int m = 0; m < 4; ++m) { const bf16_t* p = xb + (size_t)(row0 + ai * HALF + m * 16) * ldc + col0; old[m][0] = *(const u32x4*)p; old[m][1] = *(const u32x4*)(p + HALF); }
#pragma unroll
            for (int m = 0; m < 4; ++m) {
                const int row = row0 + ai * HALF + m * 16; bf16_t* p = xb + (size_t)row * ldc + col0; float s = 0.f;
                const float scale = rsb[(ui & 1) * 256 + ai * HALF + wr * 64 + m * 16 + fr];
                resid_bf16_row(acc[ai][0][m][0], acc[ai][0][m][1], scale, p, old[m][0], s); resid_bf16_row(acc[ai][1][m][0], acc[ai][1][m][1], scale, p + HALF, old[m][1], s);
                s = xsum_fq(s);
                if (fq == 0) ssq[(size_t)row * 16 + u.pn * 4 + wc] = s;
            }
        }
    }
};
template <class Epi, class Sched, bool ALIGN_EPI = false, bool SP2 = false>
__device__ __forceinline__ void gemm_phase(PG8_LAS unsigned char* lds, const Gemm g, const Sched& S, const Epi& E) {
    int tid_l = threadIdx.x; asm volatile("" : "+v"(tid_l)); const int tid = tid_l, wid = __builtin_amdgcn_readfirstlane(tid >> 6), lane = tid & 63, wr = wid >> 2, wc = wid & 3, fr = lane & 15, fq = lane >> 4;
    const int K = g.K, nt = K / BK;
    unsigned voffA[2], voffB[2];
#pragma unroll
    for (int i = 0; i < 2; ++i) { int R, C; stage_rc(tid * 16 + i * 8192, R, C); const int Rb = Epi::PERM ? ((R & ~31) + perm32(R & 31)) : R;
        voffA[i] = (unsigned)(R * K + C) * 2u; voffB[i] = (unsigned)(Rb * K + C) * 2u; }
    const size_t kstep = (size_t)(BK * 2);
    const size_t hstep = (size_t)HALF * K * 2;
    const size_t tstep = 2 * hstep;
    const unsigned ldsw = (unsigned)wid * 1024u;
    const int aoff = lds_byte(wr * 64 + fr, fq * 8), boff = lds_byte(wc * 32 + fr, fq * 8);
#define PG8_SA(b, h) (((b) * 2 + (h)) * HTB)
#define PG8_SB(b, h) ((4 + (b) * 2 + (h)) * HTB)
#define PG8_STAGE(bufoff, gbase, voff) do { _Pragma("unroll") for (int _i = 0; _i < 2; ++_i) \
        __builtin_amdgcn_global_load_lds((const unsigned*)((const char*)(gbase) + (voff)[_i]), (PG8_LAS unsigned*)(lds + (bufoff) + ldsw + _i * 8192), 16, 0, 0); } while (0)
#define PG8_LDA(dst, b, h) do { _Pragma("unroll") for (int m = 0; m < 4; ++m) _Pragma("unroll") for (int k = 0; k < 2; ++k) dst[m][k] = *(const PG8_LAS bf16x8*)(lds + PG8_SA(b, h) + aoff + m * 2048 + k * 1024); } while (0)
#define PG8_LDB(dst, b, h) do { _Pragma("unroll") for (int n = 0; n < 2; ++n) _Pragma("unroll") for (int k = 0; k < 2; ++k) dst[n][k] = *(const PG8_LAS bf16x8*)(lds + PG8_SB(b, h) + boff + n * 2048 + k * 1024); } while (0)
#define PG8_MMA(ai, bj, At, Bt) do { __builtin_amdgcn_s_setprio(1); _Pragma("unroll") for (int m = 0; m < 4; ++m) _Pragma("unroll") for (int n = 0; n < 2; ++n) _Pragma("unroll") for (int k = 0; k < 2; ++k) \
        acc[ai][bj][m][n] = __builtin_amdgcn_mfma_f32_16x16x32_bf16(Bt[n][k], At[m][k], acc[ai][bj][m][n], 0, 0, 0); __builtin_amdgcn_s_setprio(0); } while (0)
#define PG8_WAIT_V(n) asm volatile("s_waitcnt vmcnt(" #n ")" ::: "memory")
#define PG8_WAIT_L(n) asm volatile("s_waitcnt lgkmcnt(" #n ")" ::: "memory")
#define PG8_BAR __builtin_amdgcn_s_barrier()
#define PG8_SCHED __builtin_amdgcn_sched_barrier(0)
    Unit cur, nxt; int ui = 0;
    if (!S.next(0, cur)) return;
    f32x4 acc[2][2][4][2];
#pragma unroll
    for (int a = 0; a < 2; ++a)
#pragma unroll
        for (int b = 0; b < 2; ++b)
#pragma unroll
            for (int m = 0; m < 4; ++m)
#pragma unroll
                for (int n = 0; n < 2; ++n) acc[a][b][m][n] = (f32x4){0.f, 0.f, 0.f, 0.f};
    bf16x8 At[4][2], B0[2][2], B1[2][2];
    const char* cA = (const char*)g.A + (size_t)cur.pm * tstep; const char* cB = (const char*)g.Bt + (size_t)cur.pn * tstep;
    S.a_ready(cur, 0);
    if constexpr (SP2) {
        PG8_STAGE(PG8_SB(0, 0), cB, voffB); PG8_STAGE(PG8_SB(0, 1), cB + hstep, voffB); PG8_STAGE(PG8_SA(0, 0), cA, voffA); PG8_STAGE(PG8_SA(0, 1), cA + hstep, voffA);
        if (wr == 1) PG8_BAR;
        PG8_WAIT_V(2); PG8_BAR;
        PG8_STAGE(PG8_SB(1, 0), cB + kstep, voffB); PG8_STAGE(PG8_SA(1, 0), cA + kstep, voffA); PG8_STAGE(PG8_SB(1, 1), cB + hstep + kstep, voffB);
        PG8_WAIT_V(6); PG8_BAR;
    } else {
        PG8_STAGE(PG8_SB(0, 0), cB, voffB); PG8_STAGE(PG8_SA(0, 0), cA, voffA); PG8_STAGE(PG8_SB(0, 1), cB + hstep, voffB); PG8_STAGE(PG8_SA(0, 1), cA + hstep, voffA);
        if (wr == 1) PG8_BAR;
        PG8_WAIT_V(4); PG8_BAR;
        PG8_STAGE(PG8_SB(1, 0), cB + kstep, voffB); PG8_STAGE(PG8_SA(1, 0), cA + kstep, voffA); PG8_STAGE(PG8_SB(1, 1), cB + hstep + kstep, voffB);
        PG8_WAIT_V(6); PG8_BAR;
    }
    for (;;) {
        const bool has_next = S.next(ui + 1, nxt);
        const char* nA = has_next ? (const char*)g.A + (size_t)nxt.pm * tstep : cA; const char* nB = has_next ? (const char*)g.Bt + (size_t)nxt.pn * tstep : cB;
        for (int t = 0; t < nt; t += 2) {
            const bool last = (t == nt - 2);
            const char* a1 = cA + (size_t)(t + 1) * kstep;
            const char* a2 = last ? nA : cA + (size_t)(t + 2) * kstep; const char* b2 = last ? nB : cB + (size_t)(t + 2) * kstep;
            const char* a3 = a2 + kstep; const char* b3 = b2 + kstep;
            if (last && has_next) S.a_ready_inloop(nxt, ui + 1);
            if constexpr (Epi::MID_T >= 0) { if (t == Epi::MID_T) E.mid(acc, ui, wr, fr); }
            if constexpr (SP2) {
            PG8_LDB(B0, 0, 0); PG8_LDB(B1, 0, 1); PG8_SCHED; PG8_LDA(At, 0, 0); PG8_STAGE(PG8_SA(1, 1), a1 + hstep, voffA);
            PG8_WAIT_V(8); PG8_WAIT_L(0); PG8_BAR; PG8_MMA(0, 0, At, B0); PG8_MMA(0, 1, At, B1); PG8_BAR; PG8_SCHED;
            PG8_LDA(At, 0, 1); PG8_STAGE(PG8_SB(0, 0), b2, voffB); PG8_STAGE(PG8_SB(0, 1), b2 + hstep, voffB); PG8_STAGE(PG8_SA(0, 0), a2, voffA);
            PG8_WAIT_V(8); PG8_WAIT_L(0); PG8_BAR; PG8_MMA(1, 0, At, B0); PG8_MMA(1, 1, At, B1); PG8_BAR; PG8_SCHED;
            PG8_LDB(B0, 1, 0); PG8_LDB(B1, 1, 1); PG8_SCHED; PG8_LDA(At, 1, 0); PG8_STAGE(PG8_SA(0, 1), a2 + hstep, voffA);
            PG8_WAIT_V(8); PG8_WAIT_L(0); PG8_BAR; PG8_MMA(0, 0, At, B0); PG8_MMA(0, 1, At, B1); PG8_BAR; PG8_SCHED;
            PG8_LDA(At, 1, 1); PG8_STAGE(PG8_SB(1, 0), b3, voffB); PG8_STAGE(PG8_SB(1, 1), b3 + hstep, voffB); PG8_STAGE(PG8_SA(1, 0), a3, voffA);
            PG8_WAIT_V(8); PG8_WAIT_L(0); PG8_BAR; PG8_MMA(1, 0, At, B0); PG8_MMA(1, 1, At, B1); PG8_BAR; PG8_SCHED;
            } else {
            PG8_LDB(B0, 0, 0); PG8_SCHED; PG8_LDA(At, 0, 0); PG8_STAGE(PG8_SA(1, 1), a1 + hstep, voffA);
            PG8_WAIT_L(8); PG8_BAR; PG8_WAIT_L(0); PG8_MMA(0, 0, At, B0); PG8_BAR; PG8_SCHED;
            PG8_LDB(B1, 0, 1); PG8_STAGE(PG8_SB(0, 0), b2, voffB);
            PG8_BAR; PG8_WAIT_L(0); PG8_MMA(0, 1, At, B1); PG8_BAR;
            PG8_LDA(At, 0, 1); PG8_STAGE(PG8_SA(0, 0), a2, voffA);
            PG8_BAR; PG8_WAIT_L(0); PG8_MMA(1, 0, At, B0); PG8_BAR; PG8_SCHED;
            PG8_STAGE(PG8_SB(0, 1), b2 + hstep, voffB);
            PG8_WAIT_V(6); PG8_BAR; PG8_MMA(1, 1, At, B1); PG8_BAR;
            PG8_LDB(B0, 1, 0); PG8_SCHED; PG8_LDA(At, 1, 0); PG8_STAGE(PG8_SA(0, 1), a2 + hstep, voffA);
            PG8_WAIT_L(8); PG8_BAR; PG8_WAIT_L(0); PG8_MMA(0, 0, At, B0); PG8_BAR; PG8_SCHED;
            PG8_LDB(B1, 1, 1); PG8_STAGE(PG8_SB(1, 0), b3, voffB);
            PG8_BAR; PG8_WAIT_L(0); PG8_MMA(0, 1, At, B1); PG8_BAR;
            PG8_LDA(At, 1, 1); PG8_STAGE(PG8_SA(1, 0), a3, voffA);
            PG8_BAR; PG8_WAIT_L(0); PG8_MMA(1, 0, At, B0); PG8_BAR; PG8_SCHED;
            PG8_STAGE(PG8_SB(1, 1), b3 + hstep, voffB);
            PG8_WAIT_V(6); PG8_BAR; PG8_MMA(1, 1, At, B1); PG8_BAR;
            }
        }
        if constexpr (ALIGN_EPI) { if (wr == 0) PG8_BAR; }
        if constexpr (!Epi::AFTER_DRAIN) { typename Sched::Pre pre; if (has_next) S.issue(nxt, pre); E(acc, cur, ui, wr, wc, fr, fq); if (has_next) S.commit(nxt, ui + 1, pre); S.done(cur); }
        if (!has_next) break;
#pragma unroll
        for (int a = 0; a < 2; ++a)
#pragma unroll
            for (int b = 0; b < 2; ++b)
#pragma unroll
                for (int m = 0; m < 4; ++m)
#pragma unroll
                    for (int n = 0; n < 2; ++n) acc[a][b][m][n] = (f32x4){0.f, 0.f, 0.f, 0.f};
        cur = nxt; cA = nA; cB = nB; ++ui;
        if constexpr (ALIGN_EPI) { if (wr == 1) PG8_BAR; }
    }
    PG8_WAIT_V(0);
    if constexpr (!ALIGN_EPI) { if (wr == 0) PG8_BAR; }
    PG8_BAR;
    if constexpr (Epi::AFTER_DRAIN) { E.fused(acc, cur, wr, wc, fr, fq, lds, wid, lane); S.done(cur); }
#undef PG8_SA
#undef PG8_SB
#undef PG8_STAGE
#undef PG8_LDA
#undef PG8_LDB
#undef PG8_MMA
#undef PG8_WAIT_V
#undef PG8_WAIT_L
#undef PG8_BAR
#undef PG8_SCHED
}
}
#include <hip/hip_bf16.h>
#include <cmath>
namespace attn_body {
using bf16=__hip_bfloat16;
using bf16x8=__attribute__((ext_vector_type(8)))short;
using s16x4=__attribute__((ext_vector_type(4)))short;
using f32x16=__attribute__((ext_vector_type(16)))float;
using u32x4=__attribute__((ext_vector_type(4)))unsigned;
constexpr int BATCH=16,NHEAD=8,SEQ=2048,D=64,DM=2560,OPITCH=1024;
constexpr int NW=8,QBLK=32,QB=QBLK*NW,KVBLK=64,NQB=SEQ/QB;
constexpr int ATTN_PITCH=DM, ATTN_UNIT_ROWS=QB;
__device__ __forceinline__ int crow(int r,int hi){return (r&3)+8*(r>>2)+4*hi;}
#define SBAR() __builtin_amdgcn_sched_barrier(0)
__device__ __forceinline__ void cmask(f32x16&p0,f32x16&p1,int jb,int qrel,int hi){
  const float NEG=-INFINITY; int kb=64*jb+4*hi;
  #pragma unroll
  for(int r=0;r<16;++r){int kv=kb+(r&3)+8*(r>>2); if(kv>qrel)p0[r]=NEG; if(kv+32>qrel)p1[r]=NEG;}
}

constexpr int NSLOT=3, SLOTB=8192;
constexpr int TAB_TOP=2047, TAB_N=2320, TAB_COPYB=TAB_N*4, LDS_TAB=86016, LDS_TAB_END=LDS_TAB+4*TAB_COPYB;
constexpr int LDS_K=0, LDS_V=NSLOT*SLOTB, LDS_WS=2*NSLOT*SLOTB, LDS_OST=LDS_WS+NW*64*4, LDS_BYTES=LDS_OST+NW*4096;
constexpr float C2=0.125f*1.4426950408889634f;
__device__ __forceinline__ void glds16(const void*gsrc,unsigned lds_dst){unsigned keep;
  asm volatile("s_mov_b32 %0, m0\n\ts_mov_b32 m0, %2\n\ts_nop 0\n\tglobal_load_lds_dwordx4 %1, off\n\ts_mov_b32 m0, %0":"=&s"(keep):"v"(gsrc),"s"(lds_dst):"memory");}
__device__ __forceinline__ float max3f(float a,float b,float c){float r;asm("v_max3_f32 %0, %1, %2, %3":"=v"(r):"v"(a),"v"(b),"v"(c));return r;}
__device__ __forceinline__ float max2f(float a,float b){float r;asm("v_max_f32_e32 %0, %1, %2":"=v"(r):"v"(a),"v"(b));return r;}
__device__ __forceinline__ float fadd_s(float a,float b){float r;asm("v_add_f32_e32 %0, %1, %2":"=v"(r):"v"(a),"v"(b));return r;}
__device__ __forceinline__ float fsub_s(float a,float b){float r;asm("v_sub_f32_e32 %0, %1, %2":"=v"(r):"v"(a),"v"(b));return r;}
typedef float f32x4_t __attribute__((ext_vector_type(4))); typedef float f32x2_t __attribute__((ext_vector_type(2))); typedef __bf16 bf16x2_t __attribute__((ext_vector_type(2)));
__device__ __forceinline__ unsigned cvtpk_s(float lo,float hi){f32x2_t v={lo,hi};bf16x2_t b=__builtin_convertvector(v,bf16x2_t);return __builtin_bit_cast(unsigned,b);}
#define WAIT_BAR(N) asm volatile("s_waitcnt vmcnt(" #N ") lgkmcnt(0)\n\ts_barrier":::"memory")

__device__ __forceinline__ void qkt(f32x16&p0,f32x16&p1,const char*Kslot,const bf16x8*qr,int r32,int hi){
  const char*kb=Kslot+hi*1024+r32*16;
  #pragma unroll
  for(int d0=0;d0<4;++d0){
    const bf16x8 b0=*reinterpret_cast<const bf16x8*>(kb+d0*2048);
    const bf16x8 b1=*reinterpret_cast<const bf16x8*>(kb+d0*2048+512);
    {p0=__builtin_amdgcn_mfma_f32_32x32x16_bf16(b0,qr[d0],p0,0,0,0);p1=__builtin_amdgcn_mfma_f32_32x32x16_bf16(b1,qr[d0],p1,0,0,0);}}
}
typedef __attribute__((address_space(3))) const char* lds_cptr;
typedef short v4i16_t __attribute__((ext_vector_type(4)));
__device__ __forceinline__ void kload8(bf16x8*kf,lds_cptr kp){
  kf[0]=*(const __attribute__((address_space(3))) bf16x8*)(kp);      kf[1]=*(const __attribute__((address_space(3))) bf16x8*)(kp+512);
  kf[2]=*(const __attribute__((address_space(3))) bf16x8*)(kp+2048); kf[3]=*(const __attribute__((address_space(3))) bf16x8*)(kp+2560);
  kf[4]=*(const __attribute__((address_space(3))) bf16x8*)(kp+4096); kf[5]=*(const __attribute__((address_space(3))) bf16x8*)(kp+4608);
  kf[6]=*(const __attribute__((address_space(3))) bf16x8*)(kp+6144); kf[7]=*(const __attribute__((address_space(3))) bf16x8*)(kp+6656);
}
__device__ __forceinline__ void kload2(bf16x8*kf,lds_cptr kp,int j){ kf[2*j]=*(const __attribute__((address_space(3))) bf16x8*)(kp+j*2048); kf[2*j+1]=*(const __attribute__((address_space(3))) bf16x8*)(kp+j*2048+512); }
__device__ __forceinline__ s16x4 vtr(lds_cptr p){ return __builtin_bit_cast(s16x4,__builtin_amdgcn_ds_read_tr16_b64_v4i16((__attribute__((address_space(3))) v4i16_t*)p)); }
__device__ __forceinline__ float rowmax(const f32x16&p0,const f32x16&p1){
  float a=max3f(p0[0],p0[1],p1[0]),b=max3f(p0[2],p0[3],p1[1]);a=max3f(a,p1[2],p1[3]);
  #pragma unroll
  for(int r=4;r<16;r+=4){a=max3f(a,p0[r],p0[r+1]);b=max3f(b,p0[r+2],p0[r+3]);a=max3f(a,p1[r],p1[r+1]);b=max3f(b,p1[r+2],p1[r+3]);}
  const float m=max2f(a,b);
  auto rr=__builtin_amdgcn_permlane32_swap(__float_as_uint(m),__float_as_uint(m),false,false);
  return max2f(__uint_as_float(rr[0]),__uint_as_float(rr[1]));
}
__device__ __forceinline__ void pv(f32x16*o,int vb,bf16x8 pa0,bf16x8 pa1,bf16x8 pa2,bf16x8 pa3){
  #pragma unroll
  for(int d0=0;d0<2;++d0){s16x4 lo[4],hi[4];
    #pragma unroll
    for(int ks=0;ks<4;++ks){
      asm volatile("ds_read_b64_tr_b16 %0,%1 offset:%c2":"=&v"(lo[ks]):"v"(vb),"i"(d0*4096+ks*1024):"memory");
      asm volatile("ds_read_b64_tr_b16 %0,%1 offset:%c2":"=&v"(hi[ks]):"v"(vb),"i"(d0*4096+ks*1024+512):"memory");}
    asm volatile("s_waitcnt lgkmcnt(0)":::"memory");SBAR();
    #define PK(k) (bf16x8){lo[k][0],lo[k][1],lo[k][2],lo[k][3],hi[k][0],hi[k][1],hi[k][2],hi[k][3]}
    o[d0]=__builtin_amdgcn_mfma_f32_32x32x16_bf16(pa0,PK(0),o[d0],0,0,0);
    o[d0]=__builtin_amdgcn_mfma_f32_32x32x16_bf16(pa1,PK(1),o[d0],0,0,0);
    o[d0]=__builtin_amdgcn_mfma_f32_32x32x16_bf16(pa2,PK(2),o[d0],0,0,0);
    o[d0]=__builtin_amdgcn_mfma_f32_32x32x16_bf16(pa3,PK(3),o[d0],0,0,0);
    #undef PK
  }
}

#ifndef ATTN_STORE16
#define ATTN_STORE16(p,v) (*(u32x4*)(p)=(v))
#endif
template<int THRL> __device__ __forceinline__ void attn_unit(int b,int h,int qb,const bf16*Q,const bf16*__restrict__ K,const bf16*__restrict__ V,bf16*O,float*SSQA,char*shm){
  int tid_l=threadIdx.x; asm volatile("":"+v"(tid_l)); const int tid=tid_l,lane=tid&63,r32=lane&31,hi=lane>>5; const int wid=__builtin_amdgcn_readfirstlane(tid>>6);
  const long rowbase=(long)b*SEQ; const int q0=qb*QB;
  const bf16*Qw=Q+(rowbase+q0+wid*QBLK)*DM+h*D;
  typedef __attribute__((address_space(3))) const f32x4_t* tab_ptr;
  const bf16*Kh=K+rowbase*DM+h*D,*Vh=V+rowbase*DM+h*D;
  const unsigned lds0=(unsigned)(uintptr_t)shm;
  float*wsf=(float*)(shm+LDS_WS)+wid*64;
  const bf16*ksrc=Kh+(long)lane*DM+wid*8;
  const bf16*vsrc=Vh+(long)(16*(wid&3)+(lane>>2))*DM+(wid>>2)*32+(lane&3)*8;
  const unsigned kdst=lds0+LDS_K+wid*1024, vdst=lds0+LDS_V+wid*1024;
  #define DMA_K(t,slot) glds16(ksrc+(long)(t)*KVBLK*DM,(unsigned)__builtin_amdgcn_readfirstlane(kdst+(slot)))
  #define DMA_V(t,slot) glds16(vsrc+(long)(t)*KVBLK*DM,(unsigned)__builtin_amdgcn_readfirstlane(vdst+(slot)))
  const int vb0=(int)(lds0+LDS_V)+((lane>>4)&1)*32+(lane&3)*8+(4*hi+((lane&15)>>2))*64;
  const char*Kbase=shm+LDS_K; bf16x8 kf[8];
  const lds_cptr shm3=(lds_cptr)shm; const lds_cptr kp0=shm3+LDS_K+hi*1024+r32*16; const lds_cptr vp0=shm3+LDS_V+((lane>>4)&1)*32+(lane&3)*8+(4*hi+((lane&15)>>2))*64;
  const int NT=(q0+QB)/KVBLK;
  DMA_K(0,0);DMA_V(0,0);DMA_K(1,SLOTB);
  bf16x8 qr[4];
  #pragma unroll
  for(int d0=0;d0<4;++d0)qr[d0]=*reinterpret_cast<const bf16x8*>(&Qw[(long)r32*DM+d0*16+hi*8]);
  float mhat=0.f,l_reg=0.f;f32x16 o[2];o[0]=f32x16{};o[1]=f32x16{};
  const int E0_=q0+wid*QBLK+r32-4*hi; const int ta_=(TAB_TOP-E0_)&3; const lds_cptr tb0=(lds_cptr)shm+LDS_TAB+ta_*TAB_COPYB+4*((TAB_TOP-E0_)-ta_);
  #define BIAS(C0,C1,t) do{ const lds_cptr tb_=tb0+256*(t); \
    _Pragma("unroll") for(int g_=0;g_<4;++g_){ const f32x4_t v0_=*(tab_ptr)(tb_+32*g_), v1_=*(tab_ptr)(tb_+32*g_+128); \
      C0[4*g_]=v0_[0]-mhat;C0[4*g_+1]=v0_[1]-mhat;C0[4*g_+2]=v0_[2]-mhat;C0[4*g_+3]=v0_[3]-mhat; \
      C1[4*g_]=v1_[0]-mhat;C1[4*g_+1]=v1_[1]-mhat;C1[4*g_+2]=v1_[2]-mhat;C1[4*g_+3]=v1_[3]-mhat; } }while(0)
  const int qrel=wid*QBLK+r32;
  bool resc=false;
  #define START(P0,P1) do{ const float rm=rowmax(P0,P1); resc=false; \
    { const float dl=rm; mhat=fadd_s(mhat,dl); \
      _Pragma("unroll") for(int r=0;r<16;++r){P0[r]=fsub_s(P0[r],dl);P1[r]=fsub_s(P1[r],dl);} \
      } \
    _Pragma("unroll") for(int r=0;r<16;++r)P0[r]=__builtin_amdgcn_exp2f(P0[r]); }while(0)
  #define RESC() do{ if(resc){ asm volatile("s_waitcnt lgkmcnt(0)":::"memory"); \
      _Pragma("unroll") for(int d_=0;d_<2;++d_) _Pragma("unroll") for(int r=0;r<16;++r)o[d_][r]*=wsf[crow(r,hi)]; } }while(0)
  f32x16 pA0,pA1,pB0,pB1;
  int sl_prev=0,sl_cur=0,sl_next=SLOTB;
  #define ROT() do{sl_prev=sl_cur;sl_cur=sl_next;sl_next=(sl_next==(NSLOT-1)*SLOTB)?0:sl_next+SLOTB;}while(0)
  DMA_K(2,2*SLOTB);
  WAIT_BAR(3);
  BIAS(pA0,pA1,0); qkt(pA0,pA1,Kbase,qr,r32,hi);asm volatile("s_nop 15\n\ts_nop 7":"+v"(pA0),"+v"(pA1));
  START(pA0,pA1);
  _Pragma("unroll") for(int r=0;r<16;++r)pA1[r]=__builtin_amdgcn_exp2f(pA1[r]);
  WAIT_BAR(0);
  DMA_K(3,0);DMA_V(1,SLOTB);
  ROT();
  kload8(kf,kp0+sl_cur);
  WAIT_BAR(2);
  s16x4 vlo[8],vhi[8]; u32x4 pw0,pw1,pw2,pw3;
  #define PKW(P,B) cvtpk_s(P[B],P[B+1])
  #define PAF(k) __builtin_bit_cast(bf16x8,pw##k)
  #define VFR(i) (bf16x8){vlo[i][0],vlo[i][1],vlo[i][2],vlo[i][3],vhi[i][0],vhi[i][1],vhi[i][2],vhi[i][3]}
  #define PIN(x) asm volatile("":"+v"(x))
  #define MX3(a,b,c) __builtin_fmaxf(__builtin_fmaxf((a),(b)),(c))
  #define GAPA(MF,A0,A1,A2,A3,W0,W1,PW) do{ MF; sacc+=A0; sacc+=A1; sacc+=A2; sacc+=A3; PIN(sacc); W0; W1; PIN(PW); SBAR(); }while(0)
  #define EX(v) __builtin_amdgcn_exp2f(v)
  #define GAPB(MF,X,B) do{ MF; X[B]=EX(X[B]); X[B+1]=EX(X[B+1]); X[B+2]=EX(X[B+2]); X[B+3]=EX(X[B+3]); PIN(X); SBAR(); }while(0)
  #define VRD(i) do{ vlo[i]=vtr(vp_+(((i)>>2)*4096+((i)&3)*1024)); vhi[i]=vtr(vp_+(((i)>>2)*4096+((i)&3)*1024+512)); }while(0)
  #define KRD(G,j) do{ if(G){ kload2(kf,kp0+sl_next,j); SBAR(); } }while(0)
  #define STEP(C0,C1,P0,P1,t,GK,GV,GL) do{ SBAR(); BIAS(C0,C1,t); SBAR(); \
    const lds_cptr vp_=vp0+sl_prev; \
    VRD(0); SBAR(); float sacc=(P0[0]+P0[1]); \
    GAPA(C0=__builtin_amdgcn_mfma_f32_32x32x16_bf16(kf[0],qr[0],C0,0,0,0), P0[2],P0[3],P0[4],P0[5],     pw0[0]=PKW(P0,0), pw0[1]=PKW(P0,2), pw0); \
    VRD(4); SBAR(); GAPA(C1=__builtin_amdgcn_mfma_f32_32x32x16_bf16(kf[1],qr[0],C1,0,0,0), P0[6],P0[7],P0[8],P0[9],     pw0[2]=PKW(P0,4), pw0[3]=PKW(P0,6), pw0); \
    VRD(1); SBAR(); GAPA(C0=__builtin_amdgcn_mfma_f32_32x32x16_bf16(kf[2],qr[1],C0,0,0,0),   P0[10],P0[11],P0[12],P0[13], pw1[0]=PKW(P0,8), pw1[1]=PKW(P0,10), pw1); \
    VRD(5); SBAR(); GAPA(C1=__builtin_amdgcn_mfma_f32_32x32x16_bf16(kf[3],qr[1],C1,0,0,0),   P0[14],P0[15],P1[0],P1[1],   pw1[2]=PKW(P0,12),pw1[3]=PKW(P0,14), pw1); \
    VRD(2); SBAR(); GAPA(C0=__builtin_amdgcn_mfma_f32_32x32x16_bf16(kf[4],qr[2],C0,0,0,0),   P1[2],P1[3],P1[4],P1[5],     pw2[0]=PKW(P1,0), pw2[1]=PKW(P1,2), pw2); \
    VRD(6); SBAR(); GAPA(C1=__builtin_amdgcn_mfma_f32_32x32x16_bf16(kf[5],qr[2],C1,0,0,0),   P1[6],P1[7],P1[8],P1[9],     pw2[2]=PKW(P1,4), pw2[3]=PKW(P1,6), pw2); \
    VRD(3); SBAR(); GAPA(C0=__builtin_amdgcn_mfma_f32_32x32x16_bf16(kf[6],qr[3],C0,0,0,0),   P1[10],P1[11],P1[12],P1[13], pw3[0]=PKW(P1,8), pw3[1]=PKW(P1,10), pw3); \
    VRD(7); SBAR(); GAPA(C1=__builtin_amdgcn_mfma_f32_32x32x16_bf16(kf[7],qr[3],C1,0,0,0),   P1[14],P1[15],0.f,0.f,       pw3[2]=PKW(P1,12),pw3[3]=PKW(P1,14), pw3); \
    l_reg+=sacc; \
    if(GK){DMA_K((t)+3,sl_cur);} if(GV){DMA_V((t)+1,sl_next);} \
    { float a=MX3(C0[0],C0[1],C1[0]),b=MX3(C0[2],C0[3],C1[1]); a=MX3(a,C1[2],C1[3]); \
      _Pragma("unroll") for(int r=4;r<16;r+=4){a=MX3(a,C0[r],C0[r+1]);b=MX3(b,C0[r+2],C0[r+3]);a=MX3(a,C1[r],C1[r+1]);b=MX3(b,C1[r+2],C1[r+3]);} \
      float rm=__builtin_fmaxf(a,b); { auto rr=__builtin_amdgcn_permlane32_swap(__float_as_uint(rm),__float_as_uint(rm),false,false); rm=__builtin_fmaxf(__uint_as_float(rr[0]),__uint_as_float(rr[1])); } \
      resc=false; \
      if(__builtin_expect(__any(rm>(float)THRL),0)){ const float dl=__builtin_fmaxf(rm,0.f); mhat+=dl; \
        _Pragma("unroll") for(int r=0;r<16;++r){C0[r]-=dl;C1[r]-=dl;} \
        const float f=__builtin_amdgcn_exp2f(-dl); l_reg*=f; if(hi==0)wsf[r32]=f; resc=true; } } \
    SBAR(); \
    GAPB(o[0]=__builtin_amdgcn_mfma_f32_32x32x16_bf16(PAF(0),VFR(0),o[0],0,0,0), C0,0); \
    GAPB(o[1]=__builtin_amdgcn_mfma_f32_32x32x16_bf16(PAF(0),VFR(4),o[1],0,0,0), C0,4); \
    KRD(GL,0); GAPB(o[0]=__builtin_amdgcn_mfma_f32_32x32x16_bf16(PAF(1),VFR(1),o[0],0,0,0), C0,8); \
    KRD(GL,1); GAPB(o[1]=__builtin_amdgcn_mfma_f32_32x32x16_bf16(PAF(1),VFR(5),o[1],0,0,0), C0,12); \
    KRD(GL,2); GAPB(o[0]=__builtin_amdgcn_mfma_f32_32x32x16_bf16(PAF(2),VFR(2),o[0],0,0,0), C1,0); \
    KRD(GL,3); GAPB(o[1]=__builtin_amdgcn_mfma_f32_32x32x16_bf16(PAF(2),VFR(6),o[1],0,0,0), C1,4); \
    GAPB(o[0]=__builtin_amdgcn_mfma_f32_32x32x16_bf16(PAF(3),VFR(3),o[0],0,0,0), C1,8); \
    GAPB(o[1]=__builtin_amdgcn_mfma_f32_32x32x16_bf16(PAF(3),VFR(7),o[1],0,0,0), C1,12); \
    }while(0)
  int t=1;
  for(;t+5<NT;t+=2){
    STEP(pB0,pB1,pA0,pA1,t,true,true,true);     WAIT_BAR(2); RESC(); ROT();
    STEP(pA0,pA1,pB0,pB1,t+1,true,true,true);   WAIT_BAR(2); RESC(); ROT();
  }
  #define ENDW(tt) do{ if((tt)+3<NT){WAIT_BAR(2);} else if((tt)+2<NT){WAIT_BAR(1);} else {WAIT_BAR(0);} }while(0)
  for(;t+1<NT;t+=2){
    STEP(pB0,pB1,pA0,pA1,t,(t+3<NT),(t+1<NT),(t+1<NT));       ENDW(t);   RESC(); ROT();
    STEP(pA0,pA1,pB0,pB1,t+1,(t+4<NT),(t+2<NT),(t+2<NT));     ENDW(t+1); RESC(); ROT();
  }
  STEP(pB0,pB1,pA0,pA1,NT-1,false,false,false); RESC();
  { float sacc=pB0[0]+pB0[1]; _Pragma("unroll") for(int r=2;r<16;++r)sacc+=pB0[r]; _Pragma("unroll") for(int r=0;r<16;++r)sacc+=pB1[r]; l_reg+=sacc;
    pw0=(u32x4){PKW(pB0,0),PKW(pB0,2),PKW(pB0,4),PKW(pB0,6)};pw1=(u32x4){PKW(pB0,8),PKW(pB0,10),PKW(pB0,12),PKW(pB0,14)};pw2=(u32x4){PKW(pB1,0),PKW(pB1,2),PKW(pB1,4),PKW(pB1,6)};pw3=(u32x4){PKW(pB1,8),PKW(pB1,10),PKW(pB1,12),PKW(pB1,14)};
    SBAR(); pv(o,vb0+sl_cur,PAF(0),PAF(1),PAF(2),PAF(3)); }
  #undef PKW
  #undef PAF
  #undef VFR
  #undef PIN
  #undef MX3
  #undef GAPA
  #undef GAPB
  #undef EX
  #undef VRD
  #undef KRD
  #undef STEP
  #undef ENDW
  {auto rr=__builtin_amdgcn_permlane32_swap(__float_as_uint(l_reg),__float_as_uint(l_reg),false,false);l_reg=__uint_as_float(rr[0])+__uint_as_float(rr[1]);}
  if(hi==0)wsf[32+r32]=l_reg;asm volatile("s_waitcnt lgkmcnt(0)":::"memory");
  float rli[16];
  #pragma unroll
  for(int r=0;r<16;++r)rli[r]=__builtin_amdgcn_rcpf(wsf[32+crow(r,hi)]);
  bf16*Ow=O+(rowbase+q0+wid*QBLK)*OPITCH+h*D;
  { bf16*stg=(bf16*)(shm+LDS_OST)+wid*2048;
    #pragma unroll
    for(int r=0;r<16;++r){const int orow=crow(r,hi);
      #pragma unroll
      for(int d0=0;d0<2;++d0)stg[orow*64+d0*32+r32]=__float2bfloat16(o[d0][r]*rli[r]);}
    asm volatile("s_waitcnt lgkmcnt(0)":::"memory");
    #pragma unroll
    for(int i=0;i<4;++i){const int row=i*8+(lane>>3),ch=lane&7; const u32x4 v=*(const u32x4*)(stg+row*64+ch*8); ATTN_STORE16(Ow+(long)row*OPITCH+ch*8,v);
      float sq=0.f;
      #pragma unroll
      for(int e=0;e<4;++e){const float lo=__uint_as_float(v[e]<<16),hi2=__uint_as_float(v[e]&0xffff0000u); sq+=lo*lo+hi2*hi2;}
      sq+=__shfl_xor(sq,1); sq+=__shfl_xor(sq,2); sq+=__shfl_xor(sq,4);
      if(ch==0) SSQA[(rowbase+q0+wid*QBLK+row)*NHEAD+h]=sq; } }
  asm volatile("s_waitcnt lgkmcnt(0)\n\ts_barrier":::"memory");
  #undef DMA_K
  #undef DMA_V
  #undef BIAS
  #undef START
  #undef RESC
  #undef ROT
}
constexpr int ATTN_LDS_BYTES=LDS_TAB_END;
__device__ __forceinline__ void build_bias_table(char*shm){
  float*tab=(float*)(shm+LDS_TAB);
  int tid_l=threadIdx.x; asm volatile("":"+v"(tid_l));
  for(int idx=tid_l;idx<4*TAB_N;idx+=512){ const int a=idx/TAB_N,j=idx-a*TAB_N,d=TAB_TOP-(j+a);
    const int w=(d<=128?1:0)+(((d&3)==0&&d<=512)?1:0)+(((d&15)==0)?1:0);
    tab[idx]=(d<0||w==0)?-INFINITY:(w==1?0.f:(w==2?1.f:1.5849625007211562f)); }
  __syncthreads();
}
struct AttnTensors { const bf16* Q; const bf16* K; const bf16* V; bf16* O; float* SSQA; };
struct AttnUnit { int bh; int qb; };
struct StaticOrder {
  int vcu;
  __device__ __forceinline__ explicit StaticOrder(int grid,int block):vcu((block%8)*(grid/8)+block/8){}
  __device__ __forceinline__ bool next(int i,AttnUnit&u)const{ if(i>=4)return false; const int s=(vcu&1)*2; u.bh=vcu>>1; u.qb=(i==0)?s:(i==1)?7-s:(i==2)?s+1:6-s; return true; }
  __device__ __forceinline__ void a_ready(const AttnUnit&)const{}
  __device__ __forceinline__ void done(const AttnUnit&)const{}
};
template<class Sched,int THRL=8> __device__ __forceinline__ void attn_phase(char*lds,const AttnTensors&T,const Sched&S){
  AttnUnit u;
  for(int i=0;S.next(i,u);++i){ S.a_ready(u); attn_unit<THRL>(u.bh/NHEAD,u.bh%NHEAD,u.qb,T.Q,T.K,T.V,T.O,T.SSQA,lds); S.done(u); }
}
#undef SBAR
#undef WAIT_BAR
}

#define GAS __attribute__((address_space(1)))
#define LAS __attribute__((address_space(3)))
typedef unsigned short bf16;
typedef unsigned v4u __attribute__((ext_vector_type(4)));
typedef float f32x4 __attribute__((ext_vector_type(4)));

constexpr int BATCH = 16, SEQ = 2048, DM = 1024, DEPTH = 4, M = BATCH * SEQ;
constexpr int DFF = 2816, NFF = 2 * DFF, DATT = 512, DREC = 512, NPROJ = 2560, NH = 8, HD = 64;
constexpr int NWAVES = 8, NTHR = 512;
constexpr float EPS = 1e-6f;
constexpr int LDS_BYTES = 147456;
constexpr int NCHUNK = 16, CHUNK = SEQ / NCHUNK;

constexpr size_t MiB = 1u << 20;
constexpr size_t WS_CTL = 0;
constexpr size_t WS_ROPE = 1 * MiB;
constexpr size_t WS_CARRY = 2 * MiB;
constexpr size_t WS_W = 4 * MiB;
constexpr size_t W_F1I = 0, W_F1O = W_F1I + (size_t)NFF * DM * 2, W_IN = W_F1O + (size_t)DM * DFF * 2, W_OUT = W_IN + (size_t)NPROJ * DM * 2,
                 W_F2I = W_OUT + (size_t)DM * DM * 2, W_F2O = W_F2I + (size_t)NFF * DM * 2, W_END = W_F2O + (size_t)DM * DFF * 2;
static_assert(W_END == 40 * MiB, "weights");
constexpr size_t WS_XB = WS_W + 4 * 40 * MiB;
constexpr size_t WS_HP = WS_XB + 64 * MiB;
constexpr size_t WS_MG = WS_HP + 176 * MiB;
constexpr size_t WS_A = WS_MG + 64 * MiB;
constexpr size_t WS_SSQ = WS_A + 4 * MiB;
constexpr size_t WS_END = WS_SSQ + 2 * MiB;
static_assert(WS_END <= 512 * MiB, "ws");

struct Args { const float* in[20]; float* out; unsigned char* ws; };

__device__ __forceinline__ unsigned f2bf(float f) { unsigned u = __builtin_bit_cast(unsigned, f); return (u + 0x7fffu + ((u >> 16) & 1u)) >> 16; }
__device__ __forceinline__ unsigned pk2(float lo, float hi) { return f2bf(lo) | (f2bf(hi) << 16); }
__device__ __forceinline__ float bflo(unsigned u) { return __uint_as_float(u << 16); }
__device__ __forceinline__ float bfhi(unsigned u) { return __uint_as_float(u & 0xffff0000u); }
__device__ __forceinline__ float wave_sum(float v) {
#pragma unroll
    for (int o = 1; o < 64; o <<= 1) v += __shfl_xor(v, o);
    return v;
}
__device__ __forceinline__ float sigmoid_f(float x) { return 1.0f / (1.0f + __expf(-x)); }
__device__ __forceinline__ float fsigmoid(float x) { return __builtin_amdgcn_rcpf(1.0f + __builtin_amdgcn_exp2f(-1.4426950408889634f * x)); }
__device__ __forceinline__ float fgelu_tanh(float x) { const float y = 0.7978845608028654f * (x + 0.044715f * x * x * x); const float t = 1.0f - 2.0f * __builtin_amdgcn_rcpf(__builtin_amdgcn_exp2f(2.8853900817779268f * y) + 1.0f); return 0.5f * x * (1.0f + t); }
__device__ __forceinline__ float gelu_tanh_f(float x) { const float y = 0.7978845608028654f * (x + 0.044715f * x * x * x); const float t = 1.0f - 2.0f / (__expf(2.0f * y) + 1.0f); return 0.5f * x * (1.0f + t); }

__device__ __forceinline__ int dst_row(int n, int mode) {
    if (mode == 1) { const int half = n >= DFF ? 1 : 0, nn = n - half * DFF; return (nn / 128) * 256 + half * 128 + (nn % 128); }
    if (mode == 2 && n < 1024) { const int d = n & 63, hn = d >> 5, dl = d & 31; return (n & ~63) + 32 * (dl >> 4) + 8 * ((dl >> 2) & 3) + 4 * hn + (dl & 3); }
    return n;
}
__device__ __forceinline__ void transpose_item(const float* W, int K, int N, bf16* WT, int mode, const float* gain, LAS float* scr, int item, int lane) {
    const int nblk = N / 32, kb = item / nblk, nb = item % nblk, k0 = 64 * kb, n0 = 32 * nb;
    { f32x4 wv[8];
#pragma unroll
      for (int i = 0; i < 8; ++i) wv[i] = *(const f32x4*)(W + (size_t)(k0 + 8 * i + (lane >> 3)) * N + n0 + (lane & 7) * 4);
#pragma unroll
      for (int i = 0; i < 8; ++i) { const int kk = 8 * i + (lane >> 3); const float gk = gain ? gain[k0 + kk] : 1.0f; LAS float* d = scr + kk * 33 + (lane & 7) * 4;
          d[0] = wv[i][0] * gk; d[1] = wv[i][1] * gk; d[2] = wv[i][2] * gk; d[3] = wv[i][3] * gk; } }
    asm volatile("s_waitcnt lgkmcnt(0)" ::: "memory");
    const int c = lane & 7;
#pragma unroll
    for (int j = 0; j < 4; ++j) { const int n = (lane >> 3) + 8 * j; const LAS float* sp = scr + (8 * c) * 33 + n;
        v4u o; o.x = pk2(sp[0 * 33], sp[1 * 33]); o.y = pk2(sp[2 * 33], sp[3 * 33]); o.z = pk2(sp[4 * 33], sp[5 * 33]); o.w = pk2(sp[6 * 33], sp[7 * 33]);
        *(v4u*)(WT + (size_t)dst_row(n0 + n, mode) * K + k0 + 8 * c) = o; }
    asm volatile("s_waitcnt lgkmcnt(0)" ::: "memory");
}

__device__ __forceinline__ void rms_row_to_bf16(const float* xrow, const float* gain, bf16* orow, int lane) {
    const f32x4* xr = (const f32x4*)xrow + lane; const f32x4* gr = (const f32x4*)gain + lane;
    f32x4 v[4]; float s = 0.f;
#pragma unroll
    for (int j = 0; j < 4; ++j) { v[j] = xr[64 * j]; s += (v[j].x * v[j].x + v[j].y * v[j].y) + (v[j].z * v[j].z + v[j].w * v[j].w); }
    const float r = 1.0f / sqrtf(wave_sum(s) * (1.0f / DM) + EPS);
    unsigned long long* o8 = (unsigned long long*)orow + lane;
#pragma unroll
    for (int j = 0; j < 4; ++j) { const f32x4 g = gr[64 * j];
        o8[64 * j] = (unsigned long long)pk2(v[j].x * r * g.x, v[j].y * r * g.y) | ((unsigned long long)pk2(v[j].z * r * g.z, v[j].w * r * g.w) << 32); }
}


#define XB_TMO      128
#define XB_XCNT(j)  (256  + 64 * (j))
#define XB_XSUB(j)  (1280 + 64 * (j))
#define XB_XGEN(j)  (2304 + 64 * (j))
#define XB_TOP      3328
#define XB_TOPGEN   3392
#define XCD_BAR_WORDS 3456
#define XB_SPIN_CAP (1u << 18)

__device__ __forceinline__ unsigned xb_ld(unsigned* p)              { return __hip_atomic_load(p, __ATOMIC_RELAXED, __HIP_MEMORY_SCOPE_AGENT); }
__device__ __forceinline__ unsigned xb_add(unsigned* p, unsigned v) { return __hip_atomic_fetch_add(p, v, __ATOMIC_RELAXED, __HIP_MEMORY_SCOPE_AGENT); }
__device__ __forceinline__ unsigned xb_xcc_id() { return (unsigned)__builtin_amdgcn_s_getreg((3 << 11) | 20) & 0xFu; }
#define XB_SPIN(cond, bar) do { unsigned _sp = 0; while (cond) { __builtin_amdgcn_s_sleep(1); \
    if ((++_sp & 255u) == 0u) { if (xb_ld(&(bar)[XB_TMO])) break; if (_sp > XB_SPIN_CAP) { atomicAdd(&(bar)[XB_TMO], 1u); break; } } } } while (0)

struct XcdBarrier {
    unsigned* bar; unsigned x;
    volatile LAS unsigned* st;
};

__device__ __forceinline__ XcdBarrier xcd_barrier_post(unsigned* bar, volatile LAS unsigned* st) {
    XcdBarrier b; b.bar = bar; b.x = xb_xcc_id(); b.st = st;
    if (threadIdx.x == 0) (void)xb_add(&bar[XB_XCNT(b.x)], 1u);
    return b;
}
__device__ __forceinline__ void xcd_barrier_complete(unsigned* bar, unsigned x, unsigned& nloc, unsigned& nx) {
    const unsigned G = gridDim.x * gridDim.y * gridDim.z;
    unsigned sum, cnt, mine, sp = 0u;
    for (;;) {
        sum = 0u; cnt = 0u; mine = 0u;
#pragma unroll
        for (unsigned j = 0; j < 16; ++j) { const unsigned c = xb_ld(&bar[XB_XCNT(j)]); sum += c; cnt += (c > 0u) ? 1u : 0u; mine = (j == x) ? c : mine; }
        if (sum == G) break;
        __builtin_amdgcn_s_sleep(1);
        if ((++sp & 255u) == 0u) { if (xb_ld(&bar[XB_TMO])) break; if (sp > XB_SPIN_CAP) { atomicAdd(&bar[XB_TMO], 1u); break; } }
    }
    nloc = mine > 0u ? mine : 1u; nx = cnt > 0u ? cnt : 1u;
}

__device__ __forceinline__ void xcd_barrier(const XcdBarrier& b) {
    asm volatile("s_waitcnt vmcnt(0)" ::: "memory");
    __syncthreads();
    if (threadIdx.x == 0) {
        unsigned* bar = b.bar;
        __builtin_amdgcn_s_waitcnt(0);
        unsigned nloc = b.st[0], nx = b.st[1];
        if (nloc == 0u) { xcd_barrier_complete(bar, b.x, nloc, nx); b.st[0] = nloc; b.st[1] = nx; }
        const unsigned old = xb_add(&bar[XB_XSUB(b.x)], 1u);
        const unsigned gen = old / nloc;
        if (old + 1u == (gen + 1u) * nloc) {
            __builtin_amdgcn_fence(__ATOMIC_RELEASE, "agent");
            asm volatile("s_waitcnt vmcnt(0)" ::: "memory");
            const unsigned og = xb_add(&bar[XB_TOP], 1u);
            const unsigned tg = og / nx;
            if (og + 1u == (tg + 1u) * nx) xb_add(&bar[XB_TOPGEN], 1u);
            else XB_SPIN(xb_ld(&bar[XB_TOPGEN]) == tg, bar);
            __builtin_amdgcn_fence(__ATOMIC_ACQUIRE, "agent");
            xb_add(&bar[XB_XGEN(b.x)], 1u);
            asm volatile("s_waitcnt vmcnt(0)" ::: "memory");
        } else {
            XB_SPIN(xb_ld(&bar[XB_XGEN(b.x)]) == gen, bar);
            __builtin_amdgcn_fence(__ATOMIC_ACQUIRE, "agent");
            asm volatile("s_waitcnt vmcnt(0)" ::: "memory");
        }
    }
    __syncthreads();
}


constexpr int RG_XRB = 0, RG_XRF = RG_XRB + 128 * 72 * 2, RG_A = RG_XRF + 128 * 32 * 4, RG_U = RG_A + 128 * 32 * 4, RG_PE = RG_U + 128 * 32 * 4, RG_HIN = RG_PE + 16 * 32 * 2 * 4, RG_CW = RG_HIN + 128,
              RG_GB = RG_CW + 5 * 64 * 4, RG_YSQ = RG_GB + 128 * 32 * 2, RG_END = RG_YSQ + 128 * 33 * 4;
static_assert(RG_END <= 131072 && RG_XRF % 16 == 0 && RG_CW % 16 == 0 && RG_GB % 16 == 0, "rglru lds");
typedef short rg_bf16x8 __attribute__((ext_vector_type(8)));
__device__ __forceinline__ void rglru_unit(LAS unsigned char* lds, int unit, const bf16* PBp, bf16* MGp, float* SSQRp, const float* cw, const float* cbias, const float* wa, const float* ba, const float* wx, const float* bxp, const float* lam) {
    int tid_l = threadIdx.x; asm volatile("" : "+v"(tid_l));
    const int tid = tid_l, lane = tid & 63, wave = __builtin_amdgcn_readfirstlane(tid >> 6), fr = lane & 15, fq = lane >> 4;
    const int b = unit >> 4, g = (unit >> 1) & 7, hf = unit & 1;
    LAS unsigned short* XRB = (LAS unsigned short*)(lds + RG_XRB); LAS float* XRF = (LAS float*)(lds + RG_XRF);
    LAS float* AL = (LAS float*)(lds + RG_A); LAS float* UL = (LAS float*)(lds + RG_U);
    LAS float* PE = (LAS float*)(lds + RG_PE); LAS float* HIN = (LAS float*)(lds + RG_HIN); LAS float* CW = (LAS float*)(lds + RG_CW);
    LAS unsigned short* GBL = (LAS unsigned short*)(lds + RG_GB); LAS float* YSQ = (LAS float*)(lds + RG_YSQ);
    if (tid < 320) { const int k = tid >> 6, c = tid & 63; CW[tid] = (k < 4) ? cw[k * DREC + g * 64 + c] : cbias[g * 64 + c]; }
    if (tid < 32) HIN[tid] = 0.f;
    rg_bf16x8 wb[4][2];
#pragma unroll
    for (int nb = 0; nb < 4; ++nb)
#pragma unroll
        for (int kk = 0; kk < 2; ++kk) { const float* wsrc = ((nb >> 1) ? wx : wa) + ((size_t)g * 64 + 32 * kk + 8 * fq) * 64 + hf * 32 + 16 * (nb & 1) + fr;
            unsigned pk[4];
#pragma unroll
            for (int e = 0; e < 4; ++e) pk[e] = pk2(wsrc[(2 * e) * 64], wsrc[(2 * e + 1) * 64]);
            wb[nb][kk] = __builtin_bit_cast(rg_bf16x8, (v4u){pk[0], pk[1], pk[2], pk[3]}); }
    float gba[2], gbx[2], gsp[2];
#pragma unroll
    for (int cb = 0; cb < 2; ++cb) { const int cj = g * 64 + hf * 32 + 16 * cb + fr; gba[cb] = ba[cj]; gbx[cb] = bxp[cj]; const float lamj = lam[cj];
        gsp[cb] = -8.0f * 1.4426950408889634f * ((lamj > 0.f) ? __logf(1.0f + __expf(-lamj)) : (-lamj + __logf(1.0f + __expf(lamj)))); }
    const int ctt = tid >> 2, ch0 = (tid & 3) * 16;
    const size_t rowb = (size_t)b * SEQ;
    const bf16* xsrc = PBp + 1536 + g * 64 + ch0;
    const bf16* gsrc = PBp + 2048 + g * 64 + hf * 32 + (tid & 3) * 8;
    v4u xv[4][2]; v4u gv;
#define RG_PREFETCH(t0) do { _Pragma("unroll") for (int k = 0; k < 4; ++k) { const int tg = (t0) + ctt - 3 + k; \
        if (tg >= 0) { const bf16* p = xsrc + (rowb + tg) * NPROJ; xv[k][0] = *(const v4u*)p; xv[k][1] = *(const v4u*)(p + 8); } else { xv[k][0] = (v4u){0u, 0u, 0u, 0u}; xv[k][1] = (v4u){0u, 0u, 0u, 0u}; } } \
        gv = *(const v4u*)(gsrc + (rowb + (t0) + ctt) * NPROJ); } while (0)
    RG_PREFETCH(0);
    __syncthreads();
    const int sc = tid & 31, ss = tid >> 5;
#pragma unroll 1
    for (int ck = 0; ck < 16; ++ck) {
        const int t0 = ck * 128;
        {
            unsigned pkx[8];
#pragma unroll
            for (int q4 = 0; q4 < 4; ++q4) {
                f32x4 o = *(const LAS f32x4*)(CW + 4 * 64 + ch0 + q4 * 4);
#pragma unroll
                for (int k = 0; k < 4; ++k) { const f32x4 wv = *(const LAS f32x4*)(CW + k * 64 + ch0 + q4 * 4);
#pragma unroll
                    for (int e = 0; e < 4; ++e) { const int ch = q4 * 4 + e; const unsigned w = ((ch >> 3) ? xv[k][1] : xv[k][0])[(ch & 7) >> 1]; const float x = (ch & 1) ? bfhi(w) : bflo(w); o[e] = fmaf(wv[e], x, o[e]); } }
                pkx[2 * q4] = pk2(o[0], o[1]); pkx[2 * q4 + 1] = pk2(o[2], o[3]);
                if ((ch0 >> 5) == hf) *(LAS f32x4*)(XRF + ctt * 32 + (ch0 & 31) + q4 * 4) = o;
            }
            *(LAS v4u*)(XRB + ctt * 72 + ch0) = (v4u){pkx[0], pkx[1], pkx[2], pkx[3]};
            *(LAS v4u*)(XRB + ctt * 72 + ch0 + 8) = (v4u){pkx[4], pkx[5], pkx[6], pkx[7]};
            *(LAS v4u*)(GBL + ctt * 32 + (tid & 3) * 8) = gv;
        }
        if (ck < 15) RG_PREFETCH(t0 + 128);
        __syncthreads();
        {
            typedef float f32x4m __attribute__((ext_vector_type(4)));
            const rg_bf16x8 a0 = *(const LAS rg_bf16x8*)(XRB + (wave * 16 + fr) * 72 + 8 * fq), a1 = *(const LAS rg_bf16x8*)(XRB + (wave * 16 + fr) * 72 + 32 + 8 * fq);
            f32x4m d[4];
#pragma unroll
            for (int nb = 0; nb < 4; ++nb) { d[nb] = (f32x4m){0.f, 0.f, 0.f, 0.f};
                d[nb] = __builtin_amdgcn_mfma_f32_16x16x32_bf16(a0, wb[nb][0], d[nb], 0, 0, 0); d[nb] = __builtin_amdgcn_mfma_f32_16x16x32_bf16(a1, wb[nb][1], d[nb], 0, 0, 0); }
#pragma unroll
            for (int cb = 0; cb < 2; ++cb)
#pragma unroll
                for (int e = 0; e < 4; ++e) {
                    const int tok = wave * 16 + 4 * fq + e, cl = 16 * cb + fr;
                    const float r = fsigmoid(d[cb][e] + gba[cb]), ig = fsigmoid(d[2 + cb][e] + gbx[cb]);
                    const float a = __builtin_amdgcn_exp2f(r * gsp[cb]);
                    const float om = fmaxf(1.0f - a * a, 0.0f);
                    AL[tok * 32 + cl] = a; UL[tok * 32 + cl] = __builtin_amdgcn_sqrtf(om) * (ig * XRF[tok * 32 + cl]);
                }
        }
        __syncthreads();
        float av[8], uv[8];
#pragma unroll
        for (int k = 0; k < 8; ++k) { av[k] = AL[(ss * 8 + k) * 32 + sc]; uv[k] = UL[(ss * 8 + k) * 32 + sc]; }
        { float h = 0.f, p = 1.f;
#pragma unroll
          for (int k = 0; k < 8; ++k) { h = av[k] * h + uv[k]; p *= av[k]; }
          PE[(ss * 32 + sc) * 2] = p; PE[(ss * 32 + sc) * 2 + 1] = h; }
        __syncthreads();
        float h = HIN[sc];
        { typedef float f32x2v __attribute__((ext_vector_type(2))); f32x2v pe[15];
#pragma unroll
          for (int s2 = 0; s2 < 15; ++s2) pe[s2] = *(const LAS f32x2v*)(PE + (s2 * 32 + sc) * 2);
#pragma unroll
          for (int s2 = 0; s2 < 15; ++s2) h = (s2 < ss) ? fmaf(pe[s2].x, h, pe[s2].y) : h; }
        bf16* orow = MGp + (rowb + t0 + ss * 8) * DM + 512 + g * 64 + hf * 32 + sc;
#pragma unroll
        for (int k = 0; k < 8; ++k) { h = av[k] * h + uv[k]; const float gbf = __uint_as_float((unsigned)GBL[(ss * 8 + k) * 32 + sc] << 16); const unsigned yb = f2bf(h * fgelu_tanh(gbf)); orow[(size_t)k * DM] = (bf16)yb;
            const float yf = __uint_as_float(yb << 16); YSQ[(ss * 8 + k) * 33 + sc] = yf * yf; }
        __syncthreads();
        if (ss == 15) HIN[sc] = h;
        if (tid < 128) { float sq = 0.f;
#pragma unroll
            for (int c2 = 0; c2 < 32; ++c2) sq += YSQ[tid * 33 + c2];
            SSQRp[(rowb + t0 + tid) * 16 + g * 2 + hf] = sq; }
    }
    __syncthreads();
#undef RG_PREFETCH
}

typedef const __attribute__((address_space(4))) Args* KARGS_T;
#define PH_BEGIN int tid_ = threadIdx.x; asm volatile("" : "+v"(tid_)); int ll = l; asm volatile("" : "+s"(ll)); \
    KARGS_T ap = (KARGS_T)__builtin_amdgcn_kernarg_segment_ptr(); asm volatile("" : "+s"(ap)); unsigned char* ws = ap->ws; \
    const int tid = tid_, lane = tid & 63, wave = __builtin_amdgcn_readfirstlane(tid >> 6), gw = bx * NWAVES + wave, gt = bx * NTHR + tid; (void)lane; (void)gw; (void)gt; (void)ll;

#define x_in (ap->in[0])
#define X (ap->out)
#define XB ((bf16*)(ws + WS_XB))
#define HB ((bf16*)(ws + WS_HP))
#define PB ((bf16*)(ws + WS_HP))
#define MG ((bf16*)(ws + WS_MG))
#define SSQ ((float*)(ws + WS_SSQ))
#define SSQA ((float*)(ws + WS_A))
#define SSQR ((float*)(ws + WS_A + 2 * MiB))
#define ROPE_C ((float*)(ws + WS_ROPE))
#define ROPE_S (ROPE_C + SEQ * 32)
#define CARRY_P ((float*)(ws + WS_CARRY))
#define CARRY_E (CARRY_P + BATCH * NCHUNK * DREC)
#define Wf1i ((bf16*)(ws + WS_W + (size_t)ll * W_END + W_F1I))
#define Wf1o ((bf16*)(ws + WS_W + (size_t)ll * W_END + W_F1O))
#define Win ((bf16*)(ws + WS_W + (size_t)ll * W_END + W_IN))
#define Wout ((bf16*)(ws + WS_W + (size_t)ll * W_END + W_OUT))
#define Wf2i ((bf16*)(ws + WS_W + (size_t)ll * W_END + W_F2I))
#define Wf2o ((bf16*)(ws + WS_W + (size_t)ll * W_END + W_F2O))
#define LP(idx, stride) (ap->in[idx] + (size_t)ll * (size_t)(stride))
#define f1_norm LP(1, DM)
#define f1_wi LP(2, DM * NFF)
#define f1_wo LP(3, DFF * DM)
#define mix_norm LP(4, DM)
#define w_in LP(5, DM * NPROJ)
#define conv_w LP(6, 4 * DREC)
#define conv_b LP(7, DREC)
#define rg_wa LP(8, 8 * 64 * 64)
#define rg_ba LP(9, DREC)
#define rg_wx LP(10, 8 * 64 * 64)
#define rg_bx LP(11, DREC)
#define rg_lam LP(12, DREC)
#define attn_g LP(13, DATT)
#define rec_g LP(14, DREC)
#define w_out LP(15, DM * DM)
#define f2_norm LP(16, DM)
#define f2_wi LP(17, DM * NFF)
#define f2_wo LP(18, DFF * DM)
#define Xsrc ((ll == 0) ? x_in : (const float*)X)
__global__ void __launch_bounds__(NTHR, 2) hymba_fwd(Args args) {
    extern __shared__ __attribute__((aligned(16))) unsigned char lds_raw[];
    LAS unsigned char* lds = (LAS unsigned char*)lds_raw;
    constexpr int G = 256; const int bx = blockIdx.x; __builtin_assume(bx >= 0 && bx < 256); constexpr int NGW = G * NWAVES, NGT = G * NTHR;
    volatile LAS unsigned* MISC = (volatile LAS unsigned*)(lds + 131072 + 320);
    if (threadIdx.x < 32) MISC[threadIdx.x] = 0u;
    __syncthreads();
    { KARGS_T ap0 = (KARGS_T)__builtin_amdgcn_kernarg_segment_ptr(); (void)xcd_barrier_post((unsigned*)(ap0->ws + WS_CTL) + 4096, MISC + 8); }
#define GSYNC() do { KARGS_T apb = (KARGS_T)__builtin_amdgcn_kernarg_segment_ptr(); asm volatile("" : "+s"(apb)); XcdBarrier b_; b_.bar = (unsigned*)(apb->ws + WS_CTL) + 4096; b_.x = xb_xcc_id(); b_.st = (volatile LAS unsigned*)(lds + 131072 + 320) + 8; xcd_barrier(b_); } while (0)
    { const int l = 0; PH_BEGIN
    for (int i = gt; i < SEQ * 32; i += NGT) { const int pos = i >> 5, d = i & 31; const float inv = powf(10000.0f, -(float)(2 * d) / 64.0f); const float ang = (float)pos * inv;
        ROPE_C[i] = cosf(ang); ROPE_S[i] = sinf(ang); }
      for (int m = gw; m < M; m += NGW) {
          const f32x4* xr = (const f32x4*)(x_in + (size_t)m * DM) + lane; f32x4 v[4]; float sq = 0.f;
#pragma unroll
          for (int j = 0; j < 4; ++j) { v[j] = xr[64 * j]; sq += (v[j].x * v[j].x + v[j].y * v[j].y) + (v[j].z * v[j].z + v[j].w * v[j].w); }
          sq = wave_sum(sq);
          unsigned long long* o8 = (unsigned long long*)(XB + (size_t)m * DM) + lane;
#pragma unroll
          for (int j = 0; j < 4; ++j) o8[64 * j] = (unsigned long long)pk2(v[j].x, v[j].y) | ((unsigned long long)pk2(v[j].z, v[j].w) << 32);
          if (lane < 16) SSQ[(size_t)m * 16 + lane] = (lane == 0) ? sq : 0.f;
      } }
    for (int l = 0; l < DEPTH; ++l) {
        { PH_BEGIN
            LAS float* scr = (LAS float*)(lds + wave * 16384);
            constexpr int I_FI = (DM / 64) * (NFF / 32), I_FO = (DFF / 64) * (DM / 32), I_IN = (DM / 64) * (NPROJ / 32), I_OUT = (DM / 64) * (DM / 32);
            constexpr int NIT = 2 * (I_FI + I_FO) + I_IN + I_OUT;
            for (int it = gw; it < NIT; it += NGW) {
                int r = it;
                if (r < I_FI) { transpose_item(f1_wi, DM, NFF, Wf1i, 1, f1_norm, scr, r, lane); continue; } r -= I_FI;
                if (r < I_FO) { transpose_item(f1_wo, DFF, DM, Wf1o, 0, nullptr, scr, r, lane); continue; } r -= I_FO;
                if (r < I_IN) { transpose_item(w_in, DM, NPROJ, Win, 2, mix_norm, scr, r, lane); continue; } r -= I_IN;
                if (r < I_OUT) { const int k0_ = 64 * (r / (DM / 32)); transpose_item(w_out, DM, DM, Wout, 0, (k0_ < 512) ? attn_g : (rec_g - 512), scr, r, lane); continue; } r -= I_OUT;
                if (r < I_FI) { transpose_item(f2_wi, DM, NFF, Wf2i, 1, f2_norm, scr, r, lane); continue; } r -= I_FI;
                transpose_item(f2_wo, DFF, DM, Wf2o, 0, nullptr, scr, r, lane);
            }
        }
    }
    cg::this_grid().sync();

    for (int l = 0; l < DEPTH; ++l) {
        { PH_BEGIN pg8::Gemm g{XB, Wf1i, M, NFF, DM}; pg8::RsOrder S; S.init(M, NFF, G, bx); S.ssq = SSQ; S.rsb = (LAS float*)(lds + 131072 + 1024); pg8::EpiSwiGLU E{HB, DFF, S.rsb};
          pg8::gemm_phase<pg8::EpiSwiGLU, pg8::RsOrder, true, true>(lds, g, S, E); }
        GSYNC();
        { PH_BEGIN pg8::Gemm g{HB, Wf1o, M, DM, DFF}; pg8::StaticOrder S; S.init(M, DM, G, bx); pg8::EpiResid2B E{XB, SSQ, DM, 0.5f};
          pg8::gemm_phase<pg8::EpiResid2B, pg8::StaticOrder, true, true>(lds, g, S, E); }
        GSYNC();
        { PH_BEGIN pg8::Gemm g{XB, Win, M, NPROJ, DM}; pg8::RsOrder S; S.init(M, NPROJ, G, bx); S.ssq = SSQ; S.rsb = (LAS float*)(lds + 131072 + 1024); pg8::EpiProj E{PB, NPROJ, S.rsb, ROPE_C, ROPE_S};
          pg8::gemm_phase<pg8::EpiProj, pg8::RsOrder, true, true>(lds, g, S, E); }
        GSYNC();
        { PH_BEGIN
          { const int vcu = (G % 8 == 0) ? (bx % 8) * (G / 8) + bx / 8 : bx;
            for (int un = vcu; un < BATCH * 16; un += G) rglru_unit(lds, un, PB, MG, SSQR, conv_w, conv_b, rg_wa, rg_ba, rg_wx, rg_bx, rg_lam); }
          attn_body::build_bias_table((char*)lds_raw);
          const attn_body::AttnTensors AT{(const attn_body::bf16*)PB, (const attn_body::bf16*)(PB + 512), (const attn_body::bf16*)(PB + 1024), (attn_body::bf16*)MG, SSQA};
          const attn_body::StaticOrder S((int)G, (int)bx);
          attn_body::attn_phase<attn_body::StaticOrder>((char*)lds_raw, AT, S); }
        GSYNC();
        { PH_BEGIN pg8::Gemm g{MG, Wout, M, DM, DM}; pg8::MixOrder S; S.init(M, DM, G, bx); S.ssqa = SSQA; S.ssqr = SSQR; S.rsb = (LAS float*)(lds + 131072 + 1024);
          pg8::EpiResidMixB E{XB, SSQ, DM, S.rsb};
          pg8::gemm_phase<pg8::EpiResidMixB, pg8::MixOrder, true, true>(lds, g, S, E); }
        GSYNC();
        { PH_BEGIN pg8::Gemm g{XB, Wf2i, M, NFF, DM}; pg8::RsOrder S; S.init(M, NFF, G, bx); S.ssq = SSQ; S.rsb = (LAS float*)(lds + 131072 + 1024); pg8::EpiSwiGLU E{HB, DFF, S.rsb};
          pg8::gemm_phase<pg8::EpiSwiGLU, pg8::RsOrder, true, true>(lds, g, S, E); }
        GSYNC();
        { PH_BEGIN pg8::Gemm g{HB, Wf2o, M, DM, DFF}; pg8::StaticOrder S; S.init(M, DM, G, bx); pg8::EpiResid2B E{XB, SSQ, DM, 0.5f};
          pg8::gemm_phase<pg8::EpiResid2B, pg8::StaticOrder, true, true>(lds, g, S, E); }
        GSYNC();
    }
    { const int l = 0; PH_BEGIN
        const float* fg = ap->in[19];
        for (int m = gw; m < M; m += NGW) {
            const v4u w0 = *(const v4u*)(XB + (size_t)m * DM + lane * 16), w1 = *(const v4u*)(XB + (size_t)m * DM + lane * 16 + 8);
            const unsigned ww[8] = {w0.x, w0.y, w0.z, w0.w, w1.x, w1.y, w1.z, w1.w};
            float v[16]; float sq = 0.f;
#pragma unroll
            for (int i = 0; i < 8; ++i) { v[2 * i] = bflo(ww[i]); v[2 * i + 1] = bfhi(ww[i]); sq += v[2 * i] * v[2 * i] + v[2 * i + 1] * v[2 * i + 1]; }
            const float r = 1.0f / sqrtf(wave_sum(sq) * (1.0f / DM) + EPS);
            f32x4* op = (f32x4*)(X + (size_t)m * DM + lane * 16); const f32x4* gp = (const f32x4*)(fg + lane * 16);
#pragma unroll
            for (int i = 0; i < 4; ++i) { const f32x4 g4 = gp[i]; op[i] = (f32x4){v[4 * i] * r * g4[0], v[4 * i + 1] * r * g4[1], v[4 * i + 2] * r * g4[2], v[4 * i + 3] * r * g4[3]}; }
        }
    }
}

extern "C" void kernel_launch(void* const* d_in, const int* in_sizes, int n_in, void* d_out, int out_size, void* d_ws, size_t ws_size, hipStream_t stream) {
    static int grid = 0;
    if (grid == 0) {
        if (n_in != 20 || out_size != M * DM || ws_size < WS_END) { fprintf(stderr, "kernel_launch: unexpected shapes (n_in %d out %d ws %zu)\n", n_in, out_size, ws_size); grid = -1; return; }
        int dev = 0, cus = 0, per_cu = 0;
        hipGetDevice(&dev); hipDeviceGetAttribute(&cus, hipDeviceAttributeMultiprocessorCount, dev);
        if (hipFuncSetAttribute((const void*)hymba_fwd, hipFuncAttributeMaxDynamicSharedMemorySize, LDS_BYTES) != hipSuccess) { fprintf(stderr, "hipFuncSetAttribute failed\n"); grid = -1; return; }
        if (hipOccupancyMaxActiveBlocksPerMultiprocessor(&per_cu, (const void*)hymba_fwd, NTHR, LDS_BYTES) != hipSuccess || per_cu < 1) { fprintf(stderr, "occupancy query: %d\n", per_cu); per_cu = 1; }
        (void)hipGetLastError();
        if (cus < 256) { fprintf(stderr, "kernel_launch: built for a 256-CU device (got %d)\n", cus); grid = -1; return; }
        grid = 256;
    }
    if (grid < 0) return;
    if (hipMemsetAsync((char*)d_ws + WS_CTL, 0, 65536, stream) != hipSuccess) { fprintf(stderr, "memset failed\n"); return; }
    Args a{};
    for (int i = 0; i < 20; ++i) a.in[i] = (const float*)d_in[i];
    a.out = (float*)d_out; a.ws = (unsigned char*)d_ws;
    void* kargs[] = {&a};
    hipError_t e = hipLaunchCooperativeKernel((const void*)hymba_fwd, dim3(grid), dim3(NTHR), kargs, LDS_BYTES, stream);
    if (e != hipSuccess) fprintf(stderr, "cooperative launch failed: %s (grid %d)\n", hipGetErrorString(e), grid);
}
```

```cpp
#include <hip/hip_runtime.h>
#include <hip/hip_cooperative_groups.h>
#include <cstdio>
#include <cstdint>
#include <cmath>
namespace cg = cooperative_groups;
namespace pg8 {
#define PG8_LAS __attribute__((address_space(3)))
typedef unsigned short bf16_t;
typedef short bf16x8 __attribute__((ext_vector_type(8)));
typedef float f32x4 __attribute__((ext_vector_type(4)));
typedef unsigned u32x4 __attribute__((ext_vector_type(4)));
constexpr int BM = 256, BK = 64, HALF = 128, HTB = HALF * BK * 2  , STAGE_BYTES = 8 * HTB, NXCD = 8, WGM = 8;

__host__ __device__ __forceinline__ int lds_byte(int r, int c) { const int st = (r >> 4) * 2 + (c >> 5), rr = r & 15, cc = c & 31, ob = rr * 64 + cc * 2; return st * 1024 + (ob ^ (((ob >> 9) & 1) << 5)); }
__host__ __device__ __forceinline__ void stage_rc(int b, int& R, int& C) { const int st = b / 1024, sb = b % 1024, swz = sb ^ (((sb >> 9) & 1) << 5); R = (st >> 1) * 16 + swz / 64; C = (st & 1) * 32 + (swz % 64) / 2; }
__host__ __device__ __forceinline__ int perm32(int rho) { const int n = rho >> 4, i = rho & 15; return 8 * (i >> 2) + 4 * n + (i & 3); }

struct Unit { int pm, pn; };
struct Gemm { const bf16_t* A; const bf16_t* Bt; int M, N, K; };

struct StaticOrder {
    int nM, nN, nwg, G, c;
    __host__ __device__ void init(int M, int N, int G_, int c_) { nM = M / BM; nN = N / BM; nwg = nM * nN; G = G_; c = c_; }
    __host__ __device__ bool next(int i, Unit& u) const {
        const long L = (long)i * G + c; if (L >= nwg) return false;
        int wgid = (int)L; { const int q = nwg / NXCD, r = nwg % NXCD, xcd = wgid % NXCD, off = wgid / NXCD; wgid = (xcd < r ? xcd * (q + 1) : r * (q + 1) + (xcd - r) * q) + off; }
        const int nig = WGM * nN, gid = wgid / nig, fm = gid * WGM, gsz = (nM - fm) < WGM ? (nM - fm) : WGM;
        u.pm = fm + ((wgid % nig) % gsz); u.pn = (wgid % nig) / gsz; return true;
    }
    __device__ __forceinline__ void a_ready(const Unit&, int) const {}
    __device__ __forceinline__ void a_ready_inloop(const Unit&, int) const {}
    struct Pre {}; __device__ __forceinline__ void issue(const Unit&, Pre&) const {} __device__ __forceinline__ void commit(const Unit&, int, const Pre&) const {}
    __device__ __forceinline__ void done(const Unit&) const {}
};

__device__ __forceinline__ unsigned cvt_pk_bf16(float lo, float hi) { unsigned r; asm volatile("v_cvt_pk_bf16_f32 %0, %1, %2" : "=v"(r) : "v"(lo), "v"(hi)); return r; }
typedef float f32x2 __attribute__((ext_vector_type(2)));
__device__ __forceinline__ f32x2 gelu_pk(f32x2 v) {
    const f32x2 av = __builtin_elementwise_abs(v), d = av * 0.2316418882f + 1.0f;
    f32x2 t; t.x = __builtin_amdgcn_rcpf(d.x); t.y = __builtin_amdgcn_rcpf(d.y);
    f32x2 q = t * 0.5307027145f + (-0.7265760135f); q = q * t + 0.7107068705f; q = q * t + (-0.142248368f); q = q * t + 0.127414796f; q = q * t;
    const f32x2 s = (v * v) * (-0.72134752044f);
    f32x2 e; e.x = __builtin_amdgcn_exp2f(s.x); e.y = __builtin_amdgcn_exp2f(s.y);
    const f32x2 m = v * (q * e), r = v - m;
    f32x2 o; o.x = v.x < 0.f ? m.x : r.x; o.y = v.y < 0.f ? m.y : r.y; return o;
}

template <int ACT  > struct EpiBf16 {
    static constexpr bool PERM = true, AFTER_DRAIN = false; static constexpr int MID_T = -1; static_assert(ACT == 0 || ACT == 1, "EpiBf16: ACT is 0 (none) or 1 (gelu_pk)");
    bf16_t* O; int ldc; const float* bias; int split_cols; size_t split_stride; float scale0;
    __device__ __forceinline__ void operator()(const f32x4 (&acc)[2][2][4][2], const Unit& u, int ui, int wr, int wc, int fr, int fq) const {
        const int row0 = u.pm * BM + wr * 64 + fr; int colt = u.pn * BM; bf16_t* base = O;
        float sc = 1.f; if (split_cols) { const int t = colt / split_cols; base += (size_t)t * split_stride; colt -= t * split_cols; if (t == 0) sc = scale0; }
        const int col0 = colt + wc * 32 + 8 * fq, bcol0 = u.pn * BM + wc * 32 + 8 * fq;
        f32x4 bv[2][2];
#pragma unroll
        for (int bj = 0; bj < 2; ++bj)
#pragma unroll
            for (int n = 0; n < 2; ++n) bv[bj][n] = bias ? *(const f32x4*)(bias + bcol0 + bj * HALF + 4 * n) : (f32x4){0.f, 0.f, 0.f, 0.f};
#pragma unroll
        for (int ai = 0; ai < 2; ++ai)
#pragma unroll
            for (int m = 0; m < 4; ++m) { bf16_t* rowp = base + (size_t)(row0 + ai * HALF + m * 16) * ldc + col0;
#pragma unroll
                for (int bj = 0; bj < 2; ++bj) { f32x4 v0 = acc[ai][bj][m][0] + bv[bj][0], v1 = acc[ai][bj][m][1] + bv[bj][1];
                    if (ACT == 1) { f32x2 a = gelu_pk((f32x2){v0[0], v0[1]}), b = gelu_pk((f32x2){v0[2], v0[3]}), c = gelu_pk((f32x2){v1[0], v1[1]}), d = gelu_pk((f32x2){v1[2], v1[3]});
                        v0 = (f32x4){a.x, a.y, b.x, b.y}; v1 = (f32x4){c.x, c.y, d.x, d.y}; }
                    v0 = v0 * sc; v1 = v1 * sc; u32x4 w; w.x = cvt_pk_bf16(v0[0], v0[1]); w.y = cvt_pk_bf16(v0[2], v0[3]); w.z = cvt_pk_bf16(v1[0], v1[1]); w.w = cvt_pk_bf16(v1[2], v1[3]);
                    *(u32x4*)(rowp + bj * HALF) = w; } }
    }
};
__device__ __forceinline__ float xsum_fq(float s) {
    s += __uint_as_float((unsigned)__builtin_amdgcn_ds_swizzle((int)__float_as_uint(s), 0x401F));
    auto rr = __builtin_amdgcn_permlane32_swap(__float_as_uint(s), __float_as_uint(s), false, false);
    return __uint_as_float(rr[0]) + __uint_as_float(rr[1]);
}
__device__ __forceinline__ float row_rs(const float* ssq, int row) {
    typedef const __attribute__((address_space(1))) f32x4* gp_t; gp_t p = (gp_t)(ssq + (size_t)row * 16); const f32x4 a = p[0], b = p[1], c = p[2], d = p[3];
    const float s = (((a[0] + a[1]) + (a[2] + a[3])) + ((b[0] + b[1]) + (b[2] + b[3]))) + (((c[0] + c[1]) + (c[2] + c[3])) + ((d[0] + d[1]) + (d[2] + d[3])));
    return 1.0f / sqrtf(s * (1.0f / 1024.0f) + 1e-6f);
}
struct RsOrder : StaticOrder {
    const float* ssq; PG8_LAS float* rsb;
    typedef const __attribute__((address_space(1))) f32x4* gp_t;
    struct Pre { f32x4 a, b, c, d; };
    static __device__ __forceinline__ float fin(const f32x4& a, const f32x4& b, const f32x4& c, const f32x4& d) {
        const float s = (((a[0] + a[1]) + (a[2] + a[3])) + ((b[0] + b[1]) + (b[2] + b[3]))) + (((c[0] + c[1]) + (c[2] + c[3])) + ((d[0] + d[1]) + (d[2] + d[3])));
        return 1.0f / sqrtf(s * (1.0f / 1024.0f) + 1e-6f); }
    __device__ __forceinline__ void issue(const Unit& u, Pre& p) const {
        int t = threadIdx.x; asm volatile("" : "+v"(t));
        if (t < 256) { gp_t g = (gp_t)(ssq + (size_t)(u.pm * BM + t) * 16); p.a = g[0]; p.b = g[1]; p.c = g[2]; p.d = g[3]; }
    }
    __device__ __forceinline__ void commit(const Unit& u, int ui, const Pre& p) const {
        int t = threadIdx.x; asm volatile("" : "+v"(t));
        if (t < 256) rsb[(ui & 1) * 256 + t] = fin(p.a, p.b, p.c, p.d);
    }
    __device__ __forceinline__ void a_ready(const Unit& u, int ui) const { Pre p; issue(u, p); commit(u, ui, p); }
};
__device__ __forceinline__ float silu_f(float g) { return g * __builtin_amdgcn_rcpf(1.0f + __expf(-g)); }
struct EpiSwiGLU {
    static constexpr bool PERM = true, AFTER_DRAIN = false; static constexpr int MID_T = -1;
    bf16_t* H; int ldh; const PG8_LAS float* rsb;
    __device__ __forceinline__ void operator()(const f32x4 (&acc)[2][2][4][2], const Unit& u, int ui, int wr, int wc, int fr, int fq) const {
        const int row0 = u.pm * BM + wr * 64 + fr, col0 = u.pn * HALF + wc * 32 + 8 * fq;
#pragma unroll
        for (int ai = 0; ai < 2; ++ai)
#pragma unroll
            for (int m = 0; m < 4; ++m) {
                const int row = row0 + ai * HALF + m * 16;
                const float s = rsb[(ui & 1) * 256 + ai * HALF + wr * 64 + m * 16 + fr];
                f32x4 g0 = acc[ai][0][m][0] * s, g1 = acc[ai][0][m][1] * s, u0 = acc[ai][1][m][0] * s, u1 = acc[ai][1][m][1] * s;
                u32x4 w;
                w.x = cvt_pk_bf16(silu_f(g0[0]) * u0[0], silu_f(g0[1]) * u0[1]); w.y = cvt_pk_bf16(silu_f(g0[2]) * u0[2], silu_f(g0[3]) * u0[3]);
                w.z = cvt_pk_bf16(silu_f(g1[0]) * u1[0], silu_f(g1[1]) * u1[1]); w.w = cvt_pk_bf16(silu_f(g1[2]) * u1[2], silu_f(g1[3]) * u1[3]);
                *(u32x4*)(H + (size_t)row * ldh + col0) = w;
            }
    }
};
struct EpiResid {
    static constexpr bool PERM = true, AFTER_DRAIN = false; static constexpr int MID_T = -1;
    const float* base; float* out; int ldc; float scale;
    __device__ __forceinline__ void operator()(const f32x4 (&acc)[2][2][4][2], const Unit& u, int ui, int wr, int wc, int fr, int fq) const {
        const int row0 = u.pm * BM + wr * 64 + fr, col0 = u.pn * BM + wc * 32 + 8 * fq;
#pragma unroll
        for (int ai = 0; ai < 2; ++ai)
#pragma unroll
            for (int m = 0; m < 4; ++m) {
                const size_t off = (size_t)(row0 + ai * HALF + m * 16) * ldc + col0;
#pragma unroll
                for (int bj = 0; bj < 2; ++bj) {
                    const f32x4 b0 = *(const f32x4*)(base + off + bj * HALF), b1 = *(const f32x4*)(base + off + bj * HALF + 4);
                    *(f32x4*)(out + off + bj * HALF) = b0 + acc[ai][bj][m][0] * scale;
                    *(f32x4*)(out + off + bj * HALF + 4) = b1 + acc[ai][bj][m][1] * scale;
                }
            }
    }
};

struct EpiResid2 {
    static constexpr bool PERM = true, AFTER_DRAIN = false; static constexpr int MID_T = -1;
    const float* base; float* out; bf16_t* xb; float* ssq; int ldc; float scale;
    __device__ __forceinline__ void operator()(const f32x4 (&acc)[2][2][4][2], const Unit& u, int ui, int wr, int wc, int fr, int fq) const {
        const int row0 = u.pm * BM + wr * 64 + fr, col0 = u.pn * BM + wc * 32 + 8 * fq;
#pragma unroll
        for (int ai = 0; ai < 2; ++ai) {
            f32x4 bs[4][2][2];
#pragma unroll
            for (int m = 0; m < 4; ++m) { const size_t off = (size_t)(row0 + ai * HALF + m * 16) * ldc + col0;
#pragma unroll
                for (int bj = 0; bj < 2; ++bj) { bs[m][bj][0] = *(const f32x4*)(base + off + bj * HALF); bs[m][bj][1] = *(const f32x4*)(base + off + bj * HALF + 4); } }
#pragma unroll
            for (int m = 0; m < 4; ++m) {
                const int row = row0 + ai * HALF + m * 16;
                const size_t off = (size_t)row * ldc + col0;
                float s = 0.f;
#pragma unroll
                for (int bj = 0; bj < 2; ++bj) {
                    const f32x4 o0 = bs[m][bj][0] + acc[ai][bj][m][0] * scale, o1 = bs[m][bj][1] + acc[ai][bj][m][1] * scale;
                    *(f32x4*)(out + off + bj * HALF) = o0; *(f32x4*)(out + off + bj * HALF + 4) = o1;
                    s += ((o0[0] * o0[0] + o0[1] * o0[1]) + (o0[2] * o0[2] + o0[3] * o0[3])) + ((o1[0] * o1[0] + o1[1] * o1[1]) + (o1[2] * o1[2] + o1[3] * o1[3]));
                    u32x4 w; w.x = cvt_pk_bf16(o0[0], o0[1]); w.y = cvt_pk_bf16(o0[2], o0[3]); w.z = cvt_pk_bf16(o1[0], o1[1]); w.w = cvt_pk_bf16(o1[2], o1[3]);
                    *(u32x4*)(xb + off + bj * HALF) = w;
                }
                s = xsum_fq(s);
                if (fq == 0) ssq[(size_t)row * 16 + u.pn * 4 + wc] = s;
            }
        }
    }
};
struct EpiProj {
    static constexpr bool PERM = true, AFTER_DRAIN = false; static constexpr int MID_T = -1;
    bf16_t* P; int ldp; const PG8_LAS float* rsb; const float* rc; const float* rsn;
    __device__ __forceinline__ void operator()(const f32x4 (&acc)[2][2][4][2], const Unit& u, int ui, int wr, int wc, int fr, int fq) const {
        typedef unsigned u32x2v __attribute__((ext_vector_type(2)));
        const int row0 = u.pm * BM + wr * 64 + fr;
        if (u.pn < 4) {
            const int dl = 16 * (wc & 1) + 4 * fq;
#pragma unroll
            for (int ai = 0; ai < 2; ++ai) {
                f32x4 cs[2][4], sn[2][4];
#pragma unroll
                for (int m = 0; m < 4; ++m) { const int t = (row0 + ai * HALF + m * 16) & 2047; cs[ai][m] = *(const f32x4*)(rc + t * 32 + dl); sn[ai][m] = *(const f32x4*)(rsn + t * 32 + dl); }
#pragma unroll
                for (int m = 0; m < 4; ++m) {
                    const int row = row0 + ai * HALF + m * 16;
                    const float r = rsb[(ui & 1) * 256 + ai * HALF + wr * 64 + m * 16 + fr];
                    bf16_t* prow = P + (size_t)row * ldp + u.pn * BM;
                    const float qs = (u.pn < 2) ? (r * 0.18033688011112042f) : r;
#pragma unroll
                    for (int bj = 0; bj < 2; ++bj) {
                        const f32x4 a = acc[ai][bj][m][0] * qs, b = acc[ai][bj][m][1] * qs;
                        const f32x4 lo = a * cs[ai][m] - b * sn[ai][m], hi = b * cs[ai][m] + a * sn[ai][m];
                        bf16_t* hp = prow + bj * HALF + 64 * (wc >> 1) + dl;
                        u32x2v wl, wh; wl.x = cvt_pk_bf16(lo[0], lo[1]); wl.y = cvt_pk_bf16(lo[2], lo[3]); wh.x = cvt_pk_bf16(hi[0], hi[1]); wh.y = cvt_pk_bf16(hi[2], hi[3]);
                        *(u32x2v*)hp = wl; *(u32x2v*)(hp + 32) = wh;
                    }
                }
            }
        } else {
#pragma unroll
            for (int ai = 0; ai < 2; ++ai)
#pragma unroll
                for (int m = 0; m < 4; ++m) {
                    const int row = row0 + ai * HALF + m * 16;
                    const float r = rsb[(ui & 1) * 256 + ai * HALF + wr * 64 + m * 16 + fr];
                    bf16_t* prow = P + (size_t)row * ldp + u.pn * BM;
#pragma unroll
                    for (int bj = 0; bj < 2; ++bj) {
                        const f32x4 v0 = acc[ai][bj][m][0] * r, v1 = acc[ai][bj][m][1] * r;
                        u32x4 w; w.x = cvt_pk_bf16(v0[0], v0[1]); w.y = cvt_pk_bf16(v0[2], v0[3]); w.z = cvt_pk_bf16(v1[0], v1[1]); w.w = cvt_pk_bf16(v1[2], v1[3]);
                        *(u32x4*)(prow + bj * HALF + wc * 32 + 8 * fq) = w;
                    }
                }
        }
    }
};

struct MixOrder : StaticOrder {
    const float* ssqa; const float* ssqr; PG8_LAS float* rsb;
    typedef const __attribute__((address_space(1))) f32x4* gp_t;
    struct Pre { f32x4 a0, a1, r0, r1; };
    __device__ __forceinline__ void issue(const Unit& u, Pre& p) const {
        int t = threadIdx.x; asm volatile("" : "+v"(t));
        if (t < 256) { const int row = u.pm * BM + t; gp_t pa = (gp_t)(ssqa + (size_t)row * 8), pr = (gp_t)(ssqr + (size_t)row * 16);
            p.a0 = pa[0]; p.a1 = pa[1]; p.r0 = pr[0]; p.r1 = pr[1]; }
    }
    __device__ __forceinline__ void commit(const Unit& u, int ui, const Pre& p) const {
        int t = threadIdx.x; asm volatile("" : "+v"(t));
        if (t < 256) {
            gp_t pr = (gp_t)(ssqr + (size_t)(u.pm * BM + t) * 16); const f32x4 r2 = pr[2], r3 = pr[3];
            const float sa = ((p.a0[0] + p.a0[1]) + (p.a0[2] + p.a0[3])) + ((p.a1[0] + p.a1[1]) + (p.a1[2] + p.a1[3]));
            const float sr = (((p.r0[0] + p.r0[1]) + (p.r0[2] + p.r0[3])) + ((p.r1[0] + p.r1[1]) + (p.r1[2] + p.r1[3]))) + (((r2[0] + r2[1]) + (r2[2] + r2[3])) + ((r3[0] + r3[1]) + (r3[2] + r3[3])));
            const float ra = 1.0f / sqrtf(sa * (1.0f / 512.0f) + 1e-6f), rr = 1.0f / sqrtf(sr * (1.0f / 512.0f) + 1e-6f);
            rsb[(ui & 1) * 256 + t] = rr; rsb[512 + (ui & 1) * 256 + t] = ra / rr;
        }
    }
    __device__ __forceinline__ void a_ready(const Unit& u, int ui) const { Pre p; issue(u, p); commit(u, ui, p); }
};
struct EpiResidMix {
    static constexpr bool PERM = true, AFTER_DRAIN = false; static constexpr int MID_T = 8;
    const float* base; float* out; bf16_t* xb; float* ssq; int ldc; const PG8_LAS float* rsb;
    __device__ __forceinline__ void mid(f32x4 (&acc)[2][2][4][2], int ui, int wr, int fr) const {
#pragma unroll
        for (int ai = 0; ai < 2; ++ai)
#pragma unroll
            for (int m = 0; m < 4; ++m) { const float q = rsb[512 + (ui & 1) * 256 + ai * HALF + wr * 64 + m * 16 + fr];
#pragma unroll
                for (int bj = 0; bj < 2; ++bj) { acc[ai][bj][m][0] *= q; acc[ai][bj][m][1] *= q; } }
    }
    __device__ __forceinline__ void operator()(const f32x4 (&acc)[2][2][4][2], const Unit& u, int ui, int wr, int wc, int fr, int fq) const {
        const int row0 = u.pm * BM + wr * 64 + fr, col0 = u.pn * BM + wc * 32 + 8 * fq;
#pragma unroll
        for (int ai = 0; ai < 2; ++ai) {
            f32x4 bs[4][2][2];
#pragma unroll
            for (int m = 0; m < 4; ++m) { const size_t off = (size_t)(row0 + ai * HALF + m * 16) * ldc + col0;
#pragma unroll
                for (int bj = 0; bj < 2; ++bj) { bs[m][bj][0] = *(const f32x4*)(base + off + bj * HALF); bs[m][bj][1] = *(const f32x4*)(base + off + bj * HALF + 4); } }
#pragma unroll
            for (int m = 0; m < 4; ++m) {
                const int row = row0 + ai * HALF + m * 16;
                const size_t off = (size_t)row * ldc + col0;
                const float scale = rsb[(ui & 1) * 256 + ai * HALF + wr * 64 + m * 16 + fr];
                float s = 0.f;
#pragma unroll
                for (int bj = 0; bj < 2; ++bj) {
                    const f32x4 o0 = bs[m][bj][0] + acc[ai][bj][m][0] * scale, o1 = bs[m][bj][1] + acc[ai][bj][m][1] * scale;
                    *(f32x4*)(out + off + bj * HALF) = o0; *(f32x4*)(out + off + bj * HALF + 4) = o1;
                    s += ((o0[0] * o0[0] + o0[1] * o0[1]) + (o0[2] * o0[2] + o0[3] * o0[3])) + ((o1[0] * o1[0] + o1[1] * o1[1]) + (o1[2] * o1[2] + o1[3] * o1[3]));
                    u32x4 w; w.x = cvt_pk_bf16(o0[0], o0[1]); w.y = cvt_pk_bf16(o0[2], o0[3]); w.z = cvt_pk_bf16(o1[0], o1[1]); w.w = cvt_pk_bf16(o1[2], o1[3]);
                    *(u32x4*)(xb + off + bj * HALF) = w;
                }
                s = xsum_fq(s);
                if (fq == 0) ssq[(size_t)row * 16 + u.pn * 4 + wc] = s;
            }
        }
    }
};

__device__ __forceinline__ void resid_bf16_row(const f32x4& a0, const f32x4& a1, float scale, bf16_t* p, const u32x4 w, float& s) {
    f32x4 o0, o1;
    o0[0] = __uint_as_float(w.x << 16) + a0[0] * scale; o0[1] = __uint_as_float(w.x & 0xffff0000u) + a0[1] * scale; o0[2] = __uint_as_float(w.y << 16) + a0[2] * scale; o0[3] = __uint_as_float(w.y & 0xffff0000u) + a0[3] * scale;
    o1[0] = __uint_as_float(w.z << 16) + a1[0] * scale; o1[1] = __uint_as_float(w.z & 0xffff0000u) + a1[1] * scale; o1[2] = __uint_as_float(w.w << 16) + a1[2] * scale; o1[3] = __uint_as_float(w.w & 0xffff0000u) + a1[3] * scale;
    u32x4 r; r.x = cvt_pk_bf16(o0[0], o0[1]); r.y = cvt_pk_bf16(o0[2], o0[3]); r.z = cvt_pk_bf16(o1[0], o1[1]); r.w = cvt_pk_bf16(o1[2], o1[3]);
    *(u32x4*)p = r;
    const float q0 = __uint_as_float(r.x << 16), q1 = __uint_as_float(r.x & 0xffff0000u), q2 = __uint_as_float(r.y << 16), q3 = __uint_as_float(r.y & 0xffff0000u);
    const float q4 = __uint_as_float(r.z << 16), q5 = __uint_as_float(r.z & 0xffff0000u), q6 = __uint_as_float(r.w << 16), q7 = __uint_as_float(r.w & 0xffff0000u);
    s += ((q0 * q0 + q1 * q1) + (q2 * q2 + q3 * q3)) + ((q4 * q4 + q5 * q5) + (q6 * q6 + q7 * q7));
}
struct EpiResid2B {
    static constexpr bool PERM = true, AFTER_DRAIN = false; static constexpr int MID_T = -1;
    bf16_t* xb; float* ssq; int ldc; float scale;
    __device__ __forceinline__ void operator()(const f32x4 (&acc)[2][2][4][2], const Unit& u, int ui, int wr, int wc, int fr, int fq) const {
        const int row0 = u.pm * BM + wr * 64 + fr, col0 = u.pn * BM + wc * 32 + 8 * fq;
#pragma unroll
        for (int ai = 0; ai < 2; ++ai) {
            u32x4 old[4][2];
#pragma unroll
            for (int m = 0; m < 4; ++m) { const bf16_t* p = xb + (size_t)(row0 + ai * HALF + m * 16) * ldc + col0; old[m][0] = *(const u32x4*)p; old[m][1] = *(const u32x4*)(p + HALF); }
#pragma unroll
            for (int m = 0; m < 4; ++m) {
                const int row = row0 + ai * HALF + m * 16; bf16_t* p = xb + (size_t)row * ldc + col0; float s = 0.f;
                resid_bf16_row(acc[ai][0][m][0], acc[ai][0][m][1], scale, p, old[m][0], s); resid_bf16_row(acc[ai][1][m][0], acc[ai][1][m][1], scale, p + HALF, old[m][1], s);
                s = xsum_fq(s);
                if (fq == 0) ssq[(size_t)row * 16 + u.pn * 4 + wc] = s;
            }
        }
    }
};
struct EpiResidMixB {
    static constexpr bool PERM = true, AFTER_DRAIN = false; static constexpr int MID_T = 8;
    bf16_t* xb; float* ssq; int ldc; const PG8_LAS float* rsb;
    __device__ __forceinline__ void mid(f32x4 (&acc)[2][2][4][2], int ui, int wr, int fr) const {
#pragma unroll
        for (int ai = 0; ai < 2; ++ai)
#pragma unroll
            for (int m = 0; m < 4; ++m) { const float q = rsb[512 + (ui & 1) * 256 + ai * HALF + wr * 64 + m * 16 + fr];
#pragma unroll
                for (int bj = 0; bj < 2; ++bj) { acc[ai][bj][m][0] *= q; acc[ai][bj][m][1] *= q; } }
    }
    __device__ __forceinline__ void operator()(const f32x4 (&acc)[2][2][4][2], const Unit& u, int ui, int wr, int wc, int fr, int fq) const {
        const int row0 = u.pm * BM + wr * 64 + fr, col0 = u.pn * BM + wc * 32 + 8 * fq;
#pragma unroll
        for (int ai = 0; ai < 2; ++ai) {
            u32x4 old[4][2];
#pragma unroll
            for (int m = 0; m < 4; ++m) { const bf16_t* p = xb + (size_t)(row0 + ai * HALF + m * 16) * ldc + col0; old[m][0] = *(const u32x4*)p; old[m][1] = *(const u32x4*)(p + HALF); }
#pragma unroll
            for (int m = 0; m < 4; ++m) {
                const int row = row0 + ai * HALF + m * 16; bf16_t* p = xb + (size_t)row * ldc + col0; float s = 0.f;
                const float scale = rsb[(ui & 1) * 256 + ai * HALF + wr * 64 + m * 16 + fr];
                resid_bf16_row(acc[ai][0][m][0], acc[ai][0][m][1], scale, p, old[m][0], s); resid_bf16_row(acc[ai][1][m][0], acc[ai][1][m][1], scale, p + HALF, old[m][1], s);
                s = xsum_fq(s);
                if (fq == 0) ssq[(size_t)row * 16 + u.pn * 4 + wc] = s;
            }
        }
    }
};
template <class Epi, class Sched, bool ALIGN_EPI = false, bool SP2 = false>
__device__ __forceinline__ void gemm_phase(PG8_LAS unsigned char* lds, const Gemm g, const Sched& S, const Epi& E) {
    int tid_l = threadIdx.x; asm volatile("" : "+v"(tid_l)); const int tid = tid_l, wid = __builtin_amdgcn_readfirstlane(tid >> 6), lane = tid & 63, wr = wid >> 2, wc = wid & 3, fr = lane & 15, fq = lane >> 4;
    const int K = g.K, nt = K / BK;
    unsigned voffA[2], voffB[2];
#pragma unroll
    for (int i = 0; i < 2; ++i) { int R, C; stage_rc(tid * 16 + i * 8192, R, C); const int Rb = Epi::PERM ? ((R & ~31) + perm32(R & 31)) : R;
        voffA[i] = (unsigned)(R * K + C) * 2u; voffB[i] = (unsigned)(Rb * K + C) * 2u; }
    const size_t kstep = (size_t)(BK * 2);
    const size_t hstep = (size_t)HALF * K * 2;
    const size_t tstep = 2 * hstep;
    const unsigned ldsw = (unsigned)wid * 1024u;
    const int aoff = lds_byte(wr * 64 + fr, fq * 8), boff = lds_byte(wc * 32 + fr, fq * 8);
#define PG8_SA(b, h) (((b) * 2 + (h)) * HTB)
#define PG8_SB(b, h) ((4 + (b) * 2 + (h)) * HTB)
#define PG8_STAGE(bufoff, gbase, voff) do { _Pragma("unroll") for (int _i = 0; _i < 2; ++_i) \
        __builtin_amdgcn_global_load_lds((const unsigned*)((const char*)(gbase) + (voff)[_i]), (PG8_LAS unsigned*)(lds + (bufoff) + ldsw + _i * 8192), 16, 0, 0); } while (0)
#define PG8_LDA(dst, b, h) do { _Pragma("unroll") for (int m = 0; m < 4; ++m) _Pragma("unroll") for (int k = 0; k < 2; ++k) dst[m][k] = *(const PG8_LAS bf16x8*)(lds + PG8_SA(b, h) + aoff + m * 2048 + k * 1024); } while (0)
#define PG8_LDB(dst, b, h) do { _Pragma("unroll") for (int n = 0; n < 2; ++n) _Pragma("unroll") for (int k = 0; k < 2; ++k) dst[n][k] = *(const PG8_LAS bf16x8*)(lds + PG8_SB(b, h) + boff + n * 2048 + k * 1024); } while (0)
#define PG8_MMA(ai, bj, At, Bt) do { __builtin_amdgcn_s_setprio(1); _Pragma("unroll") for (int m = 0; m < 4; ++m) _Pragma("unroll") for (int n = 0; n < 2; ++n) _Pragma("unroll") for (int k = 0; k < 2; ++k) \
        acc[ai][bj][m][n] = __builtin_amdgcn_mfma_f32_16x16x32_bf16(Bt[n][k], At[m][k], acc[ai][bj][m][n], 0, 0, 0); __builtin_amdgcn_s_setprio(0); } while (0)
#define PG8_WAIT_V(n) asm volatile("s_waitcnt vmcnt(" #n ")" ::: "memory")
#define PG8_WAIT_L(n) asm volatile("s_waitcnt lgkmcnt(" #n ")" ::: "memory")
#define PG8_BAR __builtin_amdgcn_s_barrier()
#define PG8_SCHED __builtin_amdgcn_sched_barrier(0)
    Unit cur, nxt; int ui = 0;
    if (!S.next(0, cur)) return;
    f32x4 acc[2][2][4][2];
#pragma unroll
    for (int a = 0; a < 2; ++a)
#pragma unroll
        for (int b = 0; b < 2; ++b)
#pragma unroll
            for (int m = 0; m < 4; ++m)
#pragma unroll
                for (int n = 0; n < 2; ++n) acc[a][b][m][n] = (f32x4){0.f, 0.f, 0.f, 0.f};
    bf16x8 At[4][2], B0[2][2], B1[2][2];
    const char* cA = (const char*)g.A + (size_t)cur.pm * tstep; const char* cB = (const char*)g.Bt + (size_t)cur.pn * tstep;
    S.a_ready(cur, 0);
    if constexpr (SP2) {
        PG8_STAGE(PG8_SB(0, 0), cB, voffB); PG8_STAGE(PG8_SB(0, 1), cB + hstep, voffB); PG8_STAGE(PG8_SA(0, 0), cA, voffA); PG8_STAGE(PG8_SA(0, 1), cA + hstep, voffA);
        if (wr == 1) PG8_BAR;
        PG8_WAIT_V(2); PG8_BAR;
        PG8_STAGE(PG8_SB(1, 0), cB + kstep, voffB); PG8_STAGE(PG8_SA(1, 0), cA + kstep, voffA); PG8_STAGE(PG8_SB(1, 1), cB + hstep + kstep, voffB);
        PG8_WAIT_V(6); PG8_BAR;
    } else {
        PG8_STAGE(PG8_SB(0, 0), cB, voffB); PG8_STAGE(PG8_SA(0, 0), cA, voffA); PG8_STAGE(PG8_SB(0, 1), cB + hstep, voffB); PG8_STAGE(PG8_SA(0, 1), cA + hstep, voffA);
        if (wr == 1) PG8_BAR;
        PG8_WAIT_V(4); PG8_BAR;
        PG8_STAGE(PG8_SB(1, 0), cB + kstep, voffB); PG8_STAGE(PG8_SA(1, 0), cA + kstep, voffA); PG8_STAGE(PG8_SB(1, 1), cB + hstep + kstep, voffB);
        PG8_WAIT_V(6); PG8_BAR;
    }
    for (;;) {
        const bool has_next = S.next(ui + 1, nxt);
        const char* nA = has_next ? (const char*)g.A + (size_t)nxt.pm * tstep : cA; const char* nB = has_next ? (const char*)g.Bt + (size_t)nxt.pn * tstep : cB;
        constexpr int NSEG = (Epi::MID_T >= 0) ? 2 : 1;
#pragma unroll 1
        for (int seg = 0; seg < NSEG; ++seg) {
        const int t_lo = (seg == 0) ? 0 : Epi::MID_T, t_hi = (NSEG == 2 && seg == 0) ? Epi::MID_T : nt;
        if constexpr (Epi::MID_T >= 0) { if (seg == 1) E.mid(acc, ui, wr, fr); }
        for (int t = t_lo; t < t_hi; t += 2) {
            const bool last = (t == nt - 2);
            const char* a1 = cA + (size_t)(t + 1) * kstep;
            const char* a2 = last ? nA : cA + (size_t)(t + 2) * kstep; const char* b2 = last ? nB : cB + (size_t)(t + 2) * kstep;
            const char* a3 = a2 + kstep; const char* b3 = b2 + kstep;
            if (last && has_next) S.a_ready_inloop(nxt, ui + 1);
            if constexpr (SP2) {
            PG8_LDB(B0, 0, 0); PG8_LDB(B1, 0, 1); PG8_SCHED; PG8_LDA(At, 0, 0); PG8_STAGE(PG8_SA(1, 1), a1 + hstep, voffA);
            PG8_WAIT_V(8); PG8_WAIT_L(0); PG8_BAR; PG8_MMA(0, 0, At, B0); PG8_MMA(0, 1, At, B1); PG8_BAR; PG8_SCHED;
            PG8_LDA(At, 0, 1); PG8_STAGE(PG8_SB(0, 0), b2, voffB); PG8_STAGE(PG8_SB(0, 1), b2 + hstep, voffB); PG8_STAGE(PG8_SA(0, 0), a2, voffA);
            PG8_WAIT_V(8); PG8_WAIT_L(0); PG8_BAR; PG8_MMA(1, 0, At, B0); PG8_MMA(1, 1, At, B1); PG8_BAR; PG8_SCHED;
            PG8_LDB(B0, 1, 0); PG8_LDB(B1, 1, 1); PG8_SCHED; PG8_LDA(At, 1, 0); PG8_STAGE(PG8_SA(0, 1), a2 + hstep, voffA);
            PG8_WAIT_V(8); PG8_WAIT_L(0); PG8_BAR; PG8_MMA(0, 0, At, B0); PG8_MMA(0, 1, At, B1); PG8_BAR; PG8_SCHED;
            PG8_LDA(At, 1, 1); PG8_STAGE(PG8_SB(1, 0), b3, voffB); PG8_STAGE(PG8_SB(1, 1), b3 + hstep, voffB); PG8_STAGE(PG8_SA(1, 0), a3, voffA);
            PG8_WAIT_V(8); PG8_WAIT_L(0); PG8_BAR; PG8_MMA(1, 0, At, B0); PG8_MMA(1, 1, At, B1); PG8_BAR; PG8_SCHED;
            } else {
            PG8_LDB(B0, 0, 0); PG8_SCHED; PG8_LDA(At, 0, 0); PG8_STAGE(PG8_SA(1, 1), a1 + hstep, voffA);
            PG8_WAIT_L(8); PG8_BAR; PG8_WAIT_L(0); PG8_MMA(0, 0, At, B0); PG8_BAR; PG8_SCHED;
            PG8_LDB(B1, 0, 1); PG8_STAGE(PG8_SB(0, 0), b2, voffB);
            PG8_BAR; PG8_WAIT_L(0); PG8_MMA(0, 1, At, B1); PG8_BAR;
            PG8_LDA(At, 0, 1); PG8_STAGE(PG8_SA(0, 0), a2, voffA);
            PG8_BAR; PG8_WAIT_L(0); PG8_MMA(1, 0, At, B0); PG8_BAR; PG8_SCHED;
            PG8_STAGE(PG8_SB(0, 1), b2 + hstep, voffB);
            PG8_WAIT_V(6); PG8_BAR; PG8_MMA(1, 1, At, B1); PG8_BAR;
            PG8_LDB(B0, 1, 0); PG8_SCHED; PG8_LDA(At, 1, 0); PG8_STAGE(PG8_SA(0, 1), a2 + hstep, voffA);
            PG8_WAIT_L(8); PG8_BAR; PG8_WAIT_L(0); PG8_MMA(0, 0, At, B0); PG8_BAR; PG8_SCHED;
            PG8_LDB(B1, 1, 1); PG8_STAGE(PG8_SB(1, 0), b3, voffB);
            PG8_BAR; PG8_WAIT_L(0); PG8_MMA(0, 1, At, B1); PG8_BAR;
            PG8_LDA(At, 1, 1); PG8_STAGE(PG8_SA(1, 0), a3, voffA);
            PG8_BAR; PG8_WAIT_L(0); PG8_MMA(1, 0, At, B0); PG8_BAR; PG8_SCHED;
            PG8_STAGE(PG8_SB(1, 1), b3 + hstep, voffB);
            PG8_WAIT_V(6); PG8_BAR; PG8_MMA(1, 1, At, B1); PG8_BAR;
            }
        }
        }
        if constexpr (ALIGN_EPI) { if (wr == 0) PG8_BAR; }
        if constexpr (!Epi::AFTER_DRAIN) { typename Sched::Pre pre; if (has_next) S.issue(nxt, pre); E(acc, cur, ui, wr, wc, fr, fq); if (has_next) S.commit(nxt, ui + 1, pre); S.done(cur); }
        if (!has_next) break;
#pragma unroll
        for (int a = 0; a < 2; ++a)
#pragma unroll
            for (int b = 0; b < 2; ++b)
#pragma unroll
                for (int m = 0; m < 4; ++m)
#pragma unroll
                    for (int n = 0; n < 2; ++n) acc[a][b][m][n] = (f32x4){0.f, 0.f, 0.f, 0.f};
        cur = nxt; cA = nA; cB = nB; ++ui;
        if constexpr (ALIGN_EPI) { if (wr == 1) PG8_BAR; }
    }
    PG8_WAIT_V(0);
    if constexpr (!ALIGN_EPI) { if (wr == 0) PG8_BAR; }
    PG8_BAR;
    if constexpr (Epi::AFTER_DRAIN) { E.fused(acc, cur, wr, wc, fr, fq, lds, wid, lane); S.done(cur); }
#undef PG8_SA
#undef PG8_SB
#undef PG8_STAGE
#undef PG8_LDA
#undef PG8_LDB
#undef PG8_MMA
#undef PG8_WAIT_V
#undef PG8_WAIT_L
#undef PG8_BAR
#undef PG8_SCHED
}
}
#include <hip/hip_bf16.h>
#include <cmath>
namespace attn_body {
using bf16=__hip_bfloat16;
using bf16x8=__attribute__((ext_vector_type(8)))short;
using s16x4=__attribute__((ext_vector_type(4)))short;
using f32x16=__attribute__((ext_vector_type(16)))float;
using u32x4=__attribute__((ext_vector_type(4)))unsigned;
constexpr int BATCH=16,NHEAD=8,SEQ=2048,D=64,DM=2816,OPITCH=1024;
constexpr int NW=8,QBLK=32,QB=QBLK*NW,KVBLK=64,NQB=SEQ/QB;
constexpr int ATTN_PITCH=DM, ATTN_UNIT_ROWS=QB;
__device__ __forceinline__ int crow(int r,int hi){return (r&3)+8*(r>>2)+4*hi;}
#define SBAR() __builtin_amdgcn_sched_barrier(0)
__device__ __forceinline__ void cmask(f32x16&p0,f32x16&p1,int jb,int qrel,int hi){
  const float NEG=-INFINITY; int kb=64*jb+4*hi;
  #pragma unroll
  for(int r=0;r<16;++r){int kv=kb+(r&3)+8*(r>>2); if(kv>qrel)p0[r]=NEG; if(kv+32>qrel)p1[r]=NEG;}
}

constexpr int NSLOT=3, SLOTB=8192;
constexpr int TAB_TOP=2047, TAB_N=2320, TAB_COPYB=TAB_N*4, LDS_TAB=86016, LDS_TAB_END=LDS_TAB+4*TAB_COPYB;
constexpr int LDS_K=0, LDS_V=NSLOT*SLOTB, LDS_WS=2*NSLOT*SLOTB, LDS_OST=LDS_WS+NW*64*4, LDS_BYTES=LDS_OST+NW*4096;
constexpr float C2=0.125f*1.4426950408889634f;
__device__ __forceinline__ void glds16(const void*gsrc,unsigned lds_dst){unsigned keep;
  asm volatile("s_mov_b32 %0, m0\n\ts_mov_b32 m0, %2\n\ts_nop 0\n\tglobal_load_lds_dwordx4 %1, off\n\ts_mov_b32 m0, %0":"=&s"(keep):"v"(gsrc),"s"(lds_dst):"memory");}
__device__ __forceinline__ float max3f(float a,float b,float c){float r;asm("v_max3_f32 %0, %1, %2, %3":"=v"(r):"v"(a),"v"(b),"v"(c));return r;}
__device__ __forceinline__ float max2f(float a,float b){float r;asm("v_max_f32_e32 %0, %1, %2":"=v"(r):"v"(a),"v"(b));return r;}
__device__ __forceinline__ float fadd_s(float a,float b){float r;asm("v_add_f32_e32 %0, %1, %2":"=v"(r):"v"(a),"v"(b));return r;}
__device__ __forceinline__ float fsub_s(float a,float b){float r;asm("v_sub_f32_e32 %0, %1, %2":"=v"(r):"v"(a),"v"(b));return r;}
typedef float f32x4_t __attribute__((ext_vector_type(4))); typedef float f32x2_t __attribute__((ext_vector_type(2))); typedef __bf16 bf16x2_t __attribute__((ext_vector_type(2)));
__device__ __forceinline__ unsigned cvtpk_s(float lo,float hi){f32x2_t v={lo,hi};bf16x2_t b=__builtin_convertvector(v,bf16x2_t);return __builtin_bit_cast(unsigned,b);}
#define WAIT_BAR(N) asm volatile("s_waitcnt vmcnt(" #N ") lgkmcnt(0)\n\ts_barrier":::"memory")

__device__ __forceinline__ void qkt(f32x16&p0,f32x16&p1,const char*Kslot,const bf16x8*qr,int r32,int hi){
  const char*kb=Kslot+hi*1024+r32*16;
  #pragma unroll
  for(int d0=0;d0<4;++d0){
    const bf16x8 b0=*reinterpret_cast<const bf16x8*>(kb+d0*2048);
    const bf16x8 b1=*reinterpret_cast<const bf16x8*>(kb+d0*2048+512);
    {p0=__builtin_amdgcn_mfma_f32_32x32x16_bf16(b0,qr[d0],p0,0,0,0);p1=__builtin_amdgcn_mfma_f32_32x32x16_bf16(b1,qr[d0],p1,0,0,0);}}
}
typedef __attribute__((address_space(3))) const char* lds_cptr;
typedef short v4i16_t __attribute__((ext_vector_type(4)));
__device__ __forceinline__ void kload8(bf16x8*kf,lds_cptr kp){
  kf[0]=*(const __attribute__((address_space(3))) bf16x8*)(kp);      kf[1]=*(const __attribute__((address_space(3))) bf16x8*)(kp+512);
  kf[2]=*(const __attribute__((address_space(3))) bf16x8*)(kp+2048); kf[3]=*(const __attribute__((address_space(3))) bf16x8*)(kp+2560);
  kf[4]=*(const __attribute__((address_space(3))) bf16x8*)(kp+4096); kf[5]=*(const __attribute__((address_space(3))) bf16x8*)(kp+4608);
  kf[6]=*(const __attribute__((address_space(3))) bf16x8*)(kp+6144); kf[7]=*(const __attribute__((address_space(3))) bf16x8*)(kp+6656);
}
__device__ __forceinline__ void kload2(bf16x8*kf,lds_cptr kp,int j){ kf[2*j]=*(const __attribute__((address_space(3))) bf16x8*)(kp+j*2048); kf[2*j+1]=*(const __attribute__((address_space(3))) bf16x8*)(kp+j*2048+512); }
__device__ __forceinline__ s16x4 vtr(lds_cptr p){ return __builtin_bit_cast(s16x4,__builtin_amdgcn_ds_read_tr16_b64_v4i16((__attribute__((address_space(3))) v4i16_t*)p)); }
__device__ __forceinline__ float rowmax(const f32x16&p0,const f32x16&p1){
  float a=max3f(p0[0],p0[1],p1[0]),b=max3f(p0[2],p0[3],p1[1]);a=max3f(a,p1[2],p1[3]);
  #pragma unroll
  for(int r=4;r<16;r+=4){a=max3f(a,p0[r],p0[r+1]);b=max3f(b,p0[r+2],p0[r+3]);a=max3f(a,p1[r],p1[r+1]);b=max3f(b,p1[r+2],p1[r+3]);}
  const float m=max2f(a,b);
  auto rr=__builtin_amdgcn_permlane32_swap(__float_as_uint(m),__float_as_uint(m),false,false);
  return max2f(__uint_as_float(rr[0]),__uint_as_float(rr[1]));
}
__device__ __forceinline__ void pv(f32x16*o,int vb,bf16x8 pa0,bf16x8 pa1,bf16x8 pa2,bf16x8 pa3){
  #pragma unroll
  for(int d0=0;d0<2;++d0){s16x4 lo[4],hi[4];
    #pragma unroll
    for(int ks=0;ks<4;++ks){
      asm volatile("ds_read_b64_tr_b16 %0,%1 offset:%c2":"=&v"(lo[ks]):"v"(vb),"i"(d0*4096+ks*1024):"memory");
      asm volatile("ds_read_b64_tr_b16 %0,%1 offset:%c2":"=&v"(hi[ks]):"v"(vb),"i"(d0*4096+ks*1024+512):"memory");}
    asm volatile("s_waitcnt lgkmcnt(0)":::"memory");SBAR();
    #define PK(k) (bf16x8){lo[k][0],lo[k][1],lo[k][2],lo[k][3],hi[k][0],hi[k][1],hi[k][2],hi[k][3]}
    o[d0]=__builtin_amdgcn_mfma_f32_32x32x16_bf16(pa0,PK(0),o[d0],0,0,0);
    o[d0]=__builtin_amdgcn_mfma_f32_32x32x16_bf16(pa1,PK(1),o[d0],0,0,0);
    o[d0]=__builtin_amdgcn_mfma_f32_32x32x16_bf16(pa2,PK(2),o[d0],0,0,0);
    o[d0]=__builtin_amdgcn_mfma_f32_32x32x16_bf16(pa3,PK(3),o[d0],0,0,0);
    #undef PK
  }
}

#ifndef ATTN_STORE16
#define ATTN_STORE16(p,v) (*(u32x4*)(p)=(v))
#endif
template<int THRL> __device__ __forceinline__ void attn_unit(int b,int h,int qb,const bf16*Q,const bf16*__restrict__ K,const bf16*__restrict__ V,bf16*O,float*SSQA,char*shm){
  int tid_l=threadIdx.x; asm volatile("":"+v"(tid_l)); const int tid=tid_l,lane=tid&63,r32=lane&31,hi=lane>>5; const int wid=__builtin_amdgcn_readfirstlane(tid>>6);
  const long rowbase=(long)b*SEQ; const int q0=qb*QB;
  const bf16*Qw=Q+(rowbase+q0+wid*QBLK)*DM+h*D;
  typedef __attribute__((address_space(3))) const f32x4_t* tab_ptr;
  const bf16*Kh=K+rowbase*DM+h*D,*Vh=V+rowbase*DM+h*D;
  const unsigned lds0=(unsigned)(uintptr_t)shm;
  float*wsf=(float*)(shm+LDS_WS)+wid*64;
  const bf16*ksrc=Kh+(long)lane*DM+wid*8;
  const bf16*vsrc=Vh+(long)(16*(wid&3)+(lane>>2))*DM+(wid>>2)*32+(lane&3)*8;
  const unsigned kdst=lds0+LDS_K+wid*1024, vdst=lds0+LDS_V+wid*1024;
  #define DMA_K(t,slot) glds16(ksrc+(long)(t)*KVBLK*DM,(unsigned)__builtin_amdgcn_readfirstlane(kdst+(slot)))
  #define DMA_V(t,slot) glds16(vsrc+(long)(t)*KVBLK*DM,(unsigned)__builtin_amdgcn_readfirstlane(vdst+(slot)))
  const int vb0=(int)(lds0+LDS_V)+((lane>>4)&1)*32+(lane&3)*8+(4*hi+((lane&15)>>2))*64;
  const char*Kbase=shm+LDS_K; bf16x8 kf[8];
  const lds_cptr shm3=(lds_cptr)shm; const lds_cptr kp0=shm3+LDS_K+hi*1024+r32*16; const lds_cptr vp0=shm3+LDS_V+((lane>>4)&1)*32+(lane&3)*8+(4*hi+((lane&15)>>2))*64;
  const int NT=(q0+QB)/KVBLK;
  DMA_K(0,0);DMA_V(0,0);DMA_K(1,SLOTB);
  bf16x8 qr[4];
  #pragma unroll
  for(int d0=0;d0<4;++d0)qr[d0]=*reinterpret_cast<const bf16x8*>(&Qw[(long)r32*DM+d0*16+hi*8]);
  float mhat=0.f,l_reg=0.f;f32x16 o[2];o[0]=f32x16{};o[1]=f32x16{};
  const int E0_=q0+wid*QBLK+r32-4*hi; const int ta_=(TAB_TOP-E0_)&3; const lds_cptr tb0=(lds_cptr)shm+LDS_TAB+ta_*TAB_COPYB+4*((TAB_TOP-E0_)-ta_);
  #define BIAS(C0,C1,t) do{ const lds_cptr tb_=tb0+256*(t); \
    _Pragma("unroll") for(int g_=0;g_<4;++g_){ const f32x4_t v0_=*(tab_ptr)(tb_+32*g_), v1_=*(tab_ptr)(tb_+32*g_+128); \
      C0[4*g_]=v0_[0]-mhat;C0[4*g_+1]=v0_[1]-mhat;C0[4*g_+2]=v0_[2]-mhat;C0[4*g_+3]=v0_[3]-mhat; \
      C1[4*g_]=v1_[0]-mhat;C1[4*g_+1]=v1_[1]-mhat;C1[4*g_+2]=v1_[2]-mhat;C1[4*g_+3]=v1_[3]-mhat; } }while(0)
  const int qrel=wid*QBLK+r32;
  bool resc=false;
  #define START(P0,P1) do{ const float rm=rowmax(P0,P1); resc=false; \
    { const float dl=rm; mhat=fadd_s(mhat,dl); \
      _Pragma("unroll") for(int r=0;r<16;++r){P0[r]=fsub_s(P0[r],dl);P1[r]=fsub_s(P1[r],dl);} \
      } \
    _Pragma("unroll") for(int r=0;r<16;++r)P0[r]=__builtin_amdgcn_exp2f(P0[r]); }while(0)
  #define RESC() do{ if(resc){ asm volatile("s_waitcnt lgkmcnt(0)":::"memory"); \
      _Pragma("unroll") for(int d_=0;d_<2;++d_) _Pragma("unroll") for(int r=0;r<16;++r)o[d_][r]*=wsf[crow(r,hi)]; } }while(0)
  f32x16 pA0,pA1,pB0,pB1;
  int sl_prev=0,sl_cur=0,sl_next=SLOTB;
  #define ROT() do{sl_prev=sl_cur;sl_cur=sl_next;sl_next=(sl_next==(NSLOT-1)*SLOTB)?0:sl_next+SLOTB;}while(0)
  DMA_K(2,2*SLOTB);
  WAIT_BAR(3);
  BIAS(pA0,pA1,0); qkt(pA0,pA1,Kbase,qr,r32,hi);asm volatile("s_nop 15\n\ts_nop 7":"+v"(pA0),"+v"(pA1));
  START(pA0,pA1);
  _Pragma("unroll") for(int r=0;r<16;++r)pA1[r]=__builtin_amdgcn_exp2f(pA1[r]);
  WAIT_BAR(0);
  DMA_K(3,0);DMA_V(1,SLOTB);
  ROT();
  kload8(kf,kp0+sl_cur);
  WAIT_BAR(2);
  s16x4 vlo[8],vhi[8]; u32x4 pw0,pw1,pw2,pw3;
  #define PKW(P,B) cvtpk_s(P[B],P[B+1])
  #define PAF(k) __builtin_bit_cast(bf16x8,pw##k)
  #define VFR(i) (bf16x8){vlo[i][0],vlo[i][1],vlo[i][2],vlo[i][3],vhi[i][0],vhi[i][1],vhi[i][2],vhi[i][3]}
  #define PIN(x) asm volatile("":"+v"(x))
  #define MX3(a,b,c) __builtin_fmaxf(__builtin_fmaxf((a),(b)),(c))
  #define GAPA(MF,A0,A1,A2,A3,W0,W1,PW) do{ MF; sacc+=A0; sacc+=A1; sacc+=A2; sacc+=A3; PIN(sacc); W0; W1; PIN(PW); SBAR(); }while(0)
  #define EX(v) __builtin_amdgcn_exp2f(v)
  #define GAPB(MF,X,B) do{ MF; X[B]=EX(X[B]); X[B+1]=EX(X[B+1]); X[B+2]=EX(X[B+2]); X[B+3]=EX(X[B+3]); PIN(X); SBAR(); }while(0)
  #define VRD(i) do{ vlo[i]=vtr(vp_+(((i)>>2)*4096+((i)&3)*1024)); vhi[i]=vtr(vp_+(((i)>>2)*4096+((i)&3)*1024+512)); }while(0)
  #define KRD(G,j) do{ if(G){ kload2(kf,kp0+sl_next,j); SBAR(); } }while(0)
  #define STEP(C0,C1,P0,P1,t,GK,GV,GL) do{ SBAR(); BIAS(C0,C1,t); SBAR(); \
    const lds_cptr vp_=vp0+sl_prev; \
    VRD(0); SBAR(); float sacc=(P0[0]+P0[1]); \
    GAPA(C0=__builtin_amdgcn_mfma_f32_32x32x16_bf16(kf[0],qr[0],C0,0,0,0), P0[2],P0[3],P0[4],P0[5],     pw0[0]=PKW(P0,0), pw0[1]=PKW(P0,2), pw0); \
    VRD(4); SBAR(); GAPA(C1=__builtin_amdgcn_mfma_f32_32x32x16_bf16(kf[1],qr[0],C1,0,0,0), P0[6],P0[7],P0[8],P0[9],     pw0[2]=PKW(P0,4), pw0[3]=PKW(P0,6), pw0); \
    VRD(1); SBAR(); GAPA(C0=__builtin_amdgcn_mfma_f32_32x32x16_bf16(kf[2],qr[1],C0,0,0,0),   P0[10],P0[11],P0[12],P0[13], pw1[0]=PKW(P0,8), pw1[1]=PKW(P0,10), pw1); \
    VRD(5); SBAR(); GAPA(C1=__builtin_amdgcn_mfma_f32_32x32x16_bf16(kf[3],qr[1],C1,0,0,0),   P0[14],P0[15],P1[0],P1[1],   pw1[2]=PKW(P0,12),pw1[3]=PKW(P0,14), pw1); \
    VRD(2); SBAR(); GAPA(C0=__builtin_amdgcn_mfma_f32_32x32x16_bf16(kf[4],qr[2],C0,0,0,0),   P1[2],P1[3],P1[4],P1[5],     pw2[0]=PKW(P1,0), pw2[1]=PKW(P1,2), pw2); \
    VRD(6); SBAR(); GAPA(C1=__builtin_amdgcn_mfma_f32_32x32x16_bf16(kf[5],qr[2],C1,0,0,0),   P1[6],P1[7],P1[8],P1[9],     pw2[2]=PKW(P1,4), pw2[3]=PKW(P1,6), pw2); \
    VRD(3); SBAR(); GAPA(C0=__builtin_amdgcn_mfma_f32_32x32x16_bf16(kf[6],qr[3],C0,0,0,0),   P1[10],P1[11],P1[12],P1[13], pw3[0]=PKW(P1,8), pw3[1]=PKW(P1,10), pw3); \
    VRD(7); SBAR(); GAPA(C1=__builtin_amdgcn_mfma_f32_32x32x16_bf16(kf[7],qr[3],C1,0,0,0),   P1[14],P1[15],0.f,0.f,       pw3[2]=PKW(P1,12),pw3[3]=PKW(P1,14), pw3); \
    l_reg+=sacc; \
    if(GK){DMA_K((t)+3,sl_cur);} if(GV){DMA_V((t)+1,sl_next);} \
    { float a=MX3(C0[0],C0[1],C1[0]),b=MX3(C0[2],C0[3],C1[1]); a=MX3(a,C1[2],C1[3]); \
      _Pragma("unroll") for(int r=4;r<16;r+=4){a=MX3(a,C0[r],C0[r+1]);b=MX3(b,C0[r+2],C0[r+3]);a=MX3(a,C1[r],C1[r+1]);b=MX3(b,C1[r+2],C1[r+3]);} \
      float rm=__builtin_fmaxf(a,b); { auto rr=__builtin_amdgcn_permlane32_swap(__float_as_uint(rm),__float_as_uint(rm),false,false); rm=__builtin_fmaxf(__uint_as_float(rr[0]),__uint_as_float(rr[1])); } \
      resc=false; \
      if(__builtin_expect(__any(rm>(float)THRL),0)){ const float dl=__builtin_fmaxf(rm,0.f); mhat+=dl; \
        _Pragma("unroll") for(int r=0;r<16;++r){C0[r]-=dl;C1[r]-=dl;} \
        const float f=__builtin_amdgcn_exp2f(-dl); l_reg*=f; if(hi==0)wsf[r32]=f; resc=true; } } \
    SBAR(); \
    GAPB(o[0]=__builtin_amdgcn_mfma_f32_32x32x16_bf16(PAF(0),VFR(0),o[0],0,0,0), C0,0); \
    GAPB(o[1]=__builtin_amdgcn_mfma_f32_32x32x16_bf16(PAF(0),VFR(4),o[1],0,0,0), C0,4); \
    KRD(GL,0); GAPB(o[0]=__builtin_amdgcn_mfma_f32_32x32x16_bf16(PAF(1),VFR(1),o[0],0,0,0), C0,8); \
    KRD(GL,1); GAPB(o[1]=__builtin_amdgcn_mfma_f32_32x32x16_bf16(PAF(1),VFR(5),o[1],0,0,0), C0,12); \
    KRD(GL,2); GAPB(o[0]=__builtin_amdgcn_mfma_f32_32x32x16_bf16(PAF(2),VFR(2),o[0],0,0,0), C1,0); \
    KRD(GL,3); GAPB(o[1]=__builtin_amdgcn_mfma_f32_32x32x16_bf16(PAF(2),VFR(6),o[1],0,0,0), C1,4); \
    GAPB(o[0]=__builtin_amdgcn_mfma_f32_32x32x16_bf16(PAF(3),VFR(3),o[0],0,0,0), C1,8); \
    GAPB(o[1]=__builtin_amdgcn_mfma_f32_32x32x16_bf16(PAF(3),VFR(7),o[1],0,0,0), C1,12); \
    }while(0)
  int t=1;
  for(;t+5<NT;t+=2){
    STEP(pB0,pB1,pA0,pA1,t,true,true,true);     WAIT_BAR(2); RESC(); ROT();
    STEP(pA0,pA1,pB0,pB1,t+1,true,true,true);   WAIT_BAR(2); RESC(); ROT();
  }
  #define ENDW(tt) do{ if((tt)+3<NT){WAIT_BAR(2);} else if((tt)+2<NT){WAIT_BAR(1);} else {WAIT_BAR(0);} }while(0)
  for(;t+1<NT;t+=2){
    STEP(pB0,pB1,pA0,pA1,t,(t+3<NT),(t+1<NT),(t+1<NT));       ENDW(t);   RESC(); ROT();
    STEP(pA0,pA1,pB0,pB1,t+1,(t+4<NT),(t+2<NT),(t+2<NT));     ENDW(t+1); RESC(); ROT();
  }
  STEP(pB0,pB1,pA0,pA1,NT-1,false,false,false); RESC();
  { float sacc=pB0[0]+pB0[1]; _Pragma("unroll") for(int r=2;r<16;++r)sacc+=pB0[r]; _Pragma("unroll") for(int r=0;r<16;++r)sacc+=pB1[r]; l_reg+=sacc;
    pw0=(u32x4){PKW(pB0,0),PKW(pB0,2),PKW(pB0,4),PKW(pB0,6)};pw1=(u32x4){PKW(pB0,8),PKW(pB0,10),PKW(pB0,12),PKW(pB0,14)};pw2=(u32x4){PKW(pB1,0),PKW(pB1,2),PKW(pB1,4),PKW(pB1,6)};pw3=(u32x4){PKW(pB1,8),PKW(pB1,10),PKW(pB1,12),PKW(pB1,14)};
    SBAR(); pv(o,vb0+sl_cur,PAF(0),PAF(1),PAF(2),PAF(3)); }
  #undef PKW
  #undef PAF
  #undef VFR
  #undef PIN
  #undef MX3
  #undef GAPA
  #undef GAPB
  #undef EX
  #undef VRD
  #undef KRD
  #undef STEP
  #undef ENDW
  {auto rr=__builtin_amdgcn_permlane32_swap(__float_as_uint(l_reg),__float_as_uint(l_reg),false,false);l_reg=__uint_as_float(rr[0])+__uint_as_float(rr[1]);}
  if(hi==0)wsf[32+r32]=l_reg;asm volatile("s_waitcnt lgkmcnt(0)":::"memory");
  float rli[16];
  #pragma unroll
  for(int r=0;r<16;++r)rli[r]=__builtin_amdgcn_rcpf(wsf[32+crow(r,hi)]);
  bf16*Ow=O+(rowbase+q0+wid*QBLK)*OPITCH+h*D;
  { bf16*stg=(bf16*)(shm+LDS_OST)+wid*2048;
    #pragma unroll
    for(int r=0;r<16;++r){const int orow=crow(r,hi);
      #pragma unroll
      for(int d0=0;d0<2;++d0)stg[orow*64+d0*32+r32]=__float2bfloat16(o[d0][r]*rli[r]);}
    asm volatile("s_waitcnt lgkmcnt(0)":::"memory");
    #pragma unroll
    for(int i=0;i<4;++i){const int row=i*8+(lane>>3),ch=lane&7; const u32x4 v=*(const u32x4*)(stg+row*64+ch*8); ATTN_STORE16(Ow+(long)row*OPITCH+ch*8,v);
      float sq=0.f;
      #pragma unroll
      for(int e=0;e<4;++e){const float lo=__uint_as_float(v[e]<<16),hi2=__uint_as_float(v[e]&0xffff0000u); sq+=lo*lo+hi2*hi2;}
      sq+=__uint_as_float((unsigned)__builtin_amdgcn_ds_swizzle((int)__float_as_uint(sq),0x041F)); sq+=__uint_as_float((unsigned)__builtin_amdgcn_ds_swizzle((int)__float_as_uint(sq),0x081F)); sq+=__uint_as_float((unsigned)__builtin_amdgcn_ds_swizzle((int)__float_as_uint(sq),0x101F));
      if(ch==0) SSQA[(rowbase+q0+wid*QBLK+row)*NHEAD+h]=sq; } }
  asm volatile("s_waitcnt lgkmcnt(0)\n\ts_barrier":::"memory");
  #undef DMA_K
  #undef DMA_V
  #undef BIAS
  #undef START
  #undef RESC
  #undef ROT
}
constexpr int ATTN_LDS_BYTES=LDS_TAB_END;
__device__ __forceinline__ void build_bias_table(char*shm){
  float*tab=(float*)(shm+LDS_TAB);
  int tid_l=threadIdx.x; asm volatile("":"+v"(tid_l));
  for(int idx=tid_l;idx<4*TAB_N;idx+=512){ const int a=idx/TAB_N,j=idx-a*TAB_N,d=TAB_TOP-(j+a);
    const int w=(d<=128?1:0)+(((d&3)==0&&d<=512)?1:0)+(((d&15)==0)?1:0);
    tab[idx]=(d<0||w==0)?-INFINITY:(w==1?0.f:(w==2?1.f:1.5849625007211562f)); }
  __syncthreads();
}
struct AttnTensors { const bf16* Q; const bf16* K; const bf16* V; bf16* O; float* SSQA; };
struct AttnUnit { int bh; int qb; };
struct StaticOrder {
  int vcu;
  __device__ __forceinline__ explicit StaticOrder(int grid,int block):vcu((block%8)*(grid/8)+block/8){}
  __device__ __forceinline__ bool next(int i,AttnUnit&u)const{ if(i>=4)return false; const int s=(vcu&1)*2; u.bh=vcu>>1; u.qb=(i==0)?s:(i==1)?7-s:(i==2)?s+1:6-s; return true; }
  __device__ __forceinline__ void a_ready(const AttnUnit&)const{}
  __device__ __forceinline__ void done(const AttnUnit&)const{}
};
template<class Sched,int THRL=8> __device__ __forceinline__ void attn_phase(char*lds,const AttnTensors&T,const Sched&S){
  AttnUnit u;
  for(int i=0;S.next(i,u);++i){ S.a_ready(u); attn_unit<THRL>(u.bh/NHEAD,u.bh%NHEAD,u.qb,T.Q,T.K,T.V,T.O,T.SSQA,lds); S.done(u); }
}
#undef SBAR
#undef WAIT_BAR
}

#define GAS __attribute__((address_space(1)))
#define LAS __attribute__((address_space(3)))
typedef unsigned short bf16;
typedef unsigned v4u __attribute__((ext_vector_type(4)));
typedef float f32x4 __attribute__((ext_vector_type(4)));

constexpr int BATCH = 16, SEQ = 2048, DM = 1024, DEPTH = 4, M = BATCH * SEQ;
constexpr int DFF = 2816, NFF = 2 * DFF, DATT = 512, DREC = 512, NPROJ = 2560, NH = 8, HD = 64;
constexpr int PPITCH = 2816;
constexpr int NWAVES = 8, NTHR = 512;
constexpr float EPS = 1e-6f;
constexpr int LDS_BYTES = 147456;
constexpr int NCHUNK = 16, CHUNK = SEQ / NCHUNK;

constexpr size_t MiB = 1u << 20;
constexpr size_t WS_CTL = 0;
constexpr size_t WS_ROPE = 1 * MiB;
constexpr size_t WS_CARRY = 2 * MiB;
constexpr size_t WS_W = 4 * MiB;
constexpr size_t W_F1I = 0, W_F1O = W_F1I + (size_t)NFF * DM * 2, W_IN = W_F1O + (size_t)DM * DFF * 2, W_OUT = W_IN + (size_t)NPROJ * DM * 2,
                 W_F2I = W_OUT + (size_t)DM * DM * 2, W_F2O = W_F2I + (size_t)NFF * DM * 2, W_END = W_F2O + (size_t)DM * DFF * 2;
static_assert(W_END == 40 * MiB, "weights");
constexpr size_t WS_XB = WS_W + 4 * 40 * MiB;
constexpr size_t WS_HP = WS_XB + 64 * MiB;
constexpr size_t WS_MG = WS_HP + 176 * MiB;
constexpr size_t WS_A = WS_MG + 64 * MiB;
constexpr size_t WS_SSQ = WS_A + 4 * MiB;
constexpr size_t WS_END = WS_SSQ + 2 * MiB;
static_assert(WS_END <= 512 * MiB, "ws");

struct Args { const float* in[20]; float* out; unsigned char* ws; };

__device__ __forceinline__ unsigned f2bf(float f) { unsigned u = __builtin_bit_cast(unsigned, f); return (u + 0x7fffu + ((u >> 16) & 1u)) >> 16; }
__device__ __forceinline__ unsigned pk2(float lo, float hi) { return f2bf(lo) | (f2bf(hi) << 16); }
__device__ __forceinline__ float bflo(unsigned u) { return __uint_as_float(u << 16); }
__device__ __forceinline__ float bfhi(unsigned u) { return __uint_as_float(u & 0xffff0000u); }
__device__ __forceinline__ float wave_sum(float v) {
    v += __uint_as_float((unsigned)__builtin_amdgcn_ds_swizzle((int)__float_as_uint(v), 0x041F)); v += __uint_as_float((unsigned)__builtin_amdgcn_ds_swizzle((int)__float_as_uint(v), 0x081F));
    v += __uint_as_float((unsigned)__builtin_amdgcn_ds_swizzle((int)__float_as_uint(v), 0x101F)); v += __uint_as_float((unsigned)__builtin_amdgcn_ds_swizzle((int)__float_as_uint(v), 0x201F));
    v += __uint_as_float((unsigned)__builtin_amdgcn_ds_swizzle((int)__float_as_uint(v), 0x401F));
    { auto rr = __builtin_amdgcn_permlane32_swap(__float_as_uint(v), __float_as_uint(v), false, false); v = __uint_as_float(rr[0]) + __uint_as_float(rr[1]); }
    return v;
}
__device__ __forceinline__ float sigmoid_f(float x) { return 1.0f / (1.0f + __expf(-x)); }
__device__ __forceinline__ float fsigmoid(float x) { return __builtin_amdgcn_rcpf(1.0f + __builtin_amdgcn_exp2f(-1.4426950408889634f * x)); }
__device__ __forceinline__ float fgelu_tanh(float x) { const float y = 0.7978845608028654f * (x + 0.044715f * x * x * x); const float t = 1.0f - 2.0f * __builtin_amdgcn_rcpf(__builtin_amdgcn_exp2f(2.8853900817779268f * y) + 1.0f); return 0.5f * x * (1.0f + t); }
__device__ __forceinline__ float gelu_tanh_f(float x) { const float y = 0.7978845608028654f * (x + 0.044715f * x * x * x); const float t = 1.0f - 2.0f / (__expf(2.0f * y) + 1.0f); return 0.5f * x * (1.0f + t); }

__device__ __forceinline__ int dst_row(int n, int mode) {
    if (mode == 1) { const int half = n >= DFF ? 1 : 0, nn = n - half * DFF; return (nn / 128) * 256 + half * 128 + (nn % 128); }
    if (mode == 2 && n < 1024) { const int d = n & 63, hn = d >> 5, dl = d & 31; return (n & ~63) + 32 * (dl >> 4) + 8 * ((dl >> 2) & 3) + 4 * hn + (dl & 3); }
    return n;
}
__device__ __forceinline__ void transpose_item(const float* W, int K, int N, bf16* WT, int mode, const float* gain, LAS float* scr, int item, int lane) {
    const int nblk = N / 32, kb = item / nblk, nb = item % nblk, k0 = 64 * kb, n0 = 32 * nb;
    { f32x4 wv[8];
#pragma unroll
      for (int i = 0; i < 8; ++i) wv[i] = *(const f32x4*)(W + (size_t)(k0 + 8 * i + (lane >> 3)) * N + n0 + (lane & 7) * 4);
#pragma unroll
      for (int i = 0; i < 8; ++i) { const int kk = 8 * i + (lane >> 3); const float gk = gain ? gain[k0 + kk] : 1.0f; LAS float* d = scr + kk * 33 + (lane & 7) * 4;
          d[0] = wv[i][0] * gk; d[1] = wv[i][1] * gk; d[2] = wv[i][2] * gk; d[3] = wv[i][3] * gk; } }
    asm volatile("s_waitcnt lgkmcnt(0)" ::: "memory");
    const int c = lane & 7;
#pragma unroll
    for (int j = 0; j < 4; ++j) { const int n = (lane >> 3) + 8 * j; const LAS float* sp = scr + (8 * c) * 33 + n;
        v4u o; o.x = pk2(sp[0 * 33], sp[1 * 33]); o.y = pk2(sp[2 * 33], sp[3 * 33]); o.z = pk2(sp[4 * 33], sp[5 * 33]); o.w = pk2(sp[6 * 33], sp[7 * 33]);
        *(v4u*)(WT + (size_t)dst_row(n0 + n, mode) * K + k0 + 8 * c) = o; }
    asm volatile("s_waitcnt lgkmcnt(0)" ::: "memory");
}

__device__ __forceinline__ void rms_row_to_bf16(const float* xrow, const float* gain, bf16* orow, int lane) {
    const f32x4* xr = (const f32x4*)xrow + lane; const f32x4* gr = (const f32x4*)gain + lane;
    f32x4 v[4]; float s = 0.f;
#pragma unroll
    for (int j = 0; j < 4; ++j) { v[j] = xr[64 * j]; s += (v[j].x * v[j].x + v[j].y * v[j].y) + (v[j].z * v[j].z + v[j].w * v[j].w); }
    const float r = 1.0f / sqrtf(wave_sum(s) * (1.0f / DM) + EPS);
    unsigned long long* o8 = (unsigned long long*)orow + lane;
#pragma unroll
    for (int j = 0; j < 4; ++j) { const f32x4 g = gr[64 * j];
        o8[64 * j] = (unsigned long long)pk2(v[j].x * r * g.x, v[j].y * r * g.y) | ((unsigned long long)pk2(v[j].z * r * g.z, v[j].w * r * g.w) << 32); }
}


#define XB_TMO      128
#define XB_XCNT(j)  (256  + 64 * (j))
#define XB_XSUB(j)  (1280 + 64 * (j))
#define XB_XGEN(j)  (2304 + 64 * (j))
#define XB_TOP      3328
#define XB_TOPGEN   3392
#define XCD_BAR_WORDS 3456
#define XB_SPIN_CAP (1u << 18)

__device__ __forceinline__ unsigned xb_ld(unsigned* p)              { return __hip_atomic_load(p, __ATOMIC_RELAXED, __HIP_MEMORY_SCOPE_AGENT); }
__device__ __forceinline__ unsigned xb_add(unsigned* p, unsigned v) { return __hip_atomic_fetch_add(p, v, __ATOMIC_RELAXED, __HIP_MEMORY_SCOPE_AGENT); }
__device__ __forceinline__ unsigned xb_xcc_id() { return (unsigned)__builtin_amdgcn_s_getreg((3 << 11) | 20) & 0xFu; }
#define XB_SPIN(cond, bar) do { unsigned _sp = 0; while (cond) { __builtin_amdgcn_s_sleep(1); \
    if ((++_sp & 255u) == 0u) { if (xb_ld(&(bar)[XB_TMO])) break; if (_sp > XB_SPIN_CAP) { atomicAdd(&(bar)[XB_TMO], 1u); break; } } } } while (0)

struct XcdBarrier {
    unsigned* bar; unsigned x;
    volatile LAS unsigned* st;
};

__device__ __forceinline__ XcdBarrier xcd_barrier_post(unsigned* bar, volatile LAS unsigned* st) {
    XcdBarrier b; b.bar = bar; b.x = xb_xcc_id(); b.st = st;
    if (threadIdx.x == 0) (void)xb_add(&bar[XB_XCNT(b.x)], 1u);
    return b;
}
__device__ __forceinline__ void xcd_barrier_complete(unsigned* bar, unsigned x, unsigned& nloc, unsigned& nx) {
    const unsigned G = gridDim.x * gridDim.y * gridDim.z;
    unsigned sum, cnt, mine, sp = 0u;
    for (;;) {
        sum = 0u; cnt = 0u; mine = 0u;
#pragma unroll
        for (unsigned j = 0; j < 16; ++j) { const unsigned c = xb_ld(&bar[XB_XCNT(j)]); sum += c; cnt += (c > 0u) ? 1u : 0u; mine = (j == x) ? c : mine; }
        if (sum == G) break;
        __builtin_amdgcn_s_sleep(1);
        if ((++sp & 255u) == 0u) { if (xb_ld(&bar[XB_TMO])) break; if (sp > XB_SPIN_CAP) { atomicAdd(&bar[XB_TMO], 1u); break; } }
    }
    nloc = mine > 0u ? mine : 1u; nx = cnt > 0u ? cnt : 1u;
}

__device__ __forceinline__ void xcd_barrier(const XcdBarrier& b) {
    asm volatile("s_waitcnt vmcnt(0)" ::: "memory");
    __syncthreads();
    if (threadIdx.x == 0) {
        unsigned* bar = b.bar;
        __builtin_amdgcn_s_waitcnt(0);
        unsigned nloc = b.st[0], nx = b.st[1];
        if (nloc == 0u) { xcd_barrier_complete(bar, b.x, nloc, nx); b.st[0] = nloc; b.st[1] = nx; }
        const unsigned old = xb_add(&bar[XB_XSUB(b.x)], 1u);
        const unsigned gen = old / nloc;
        if (old + 1u == (gen + 1u) * nloc) {
            __builtin_amdgcn_fence(__ATOMIC_RELEASE, "agent");
            asm volatile("s_waitcnt vmcnt(0)" ::: "memory");
            const unsigned og = xb_add(&bar[XB_TOP], 1u);
            const unsigned tg = og / nx;
            if (og + 1u == (tg + 1u) * nx) xb_add(&bar[XB_TOPGEN], 1u);
            else XB_SPIN(xb_ld(&bar[XB_TOPGEN]) == tg, bar);
            __builtin_amdgcn_fence(__ATOMIC_ACQUIRE, "agent");
            xb_add(&bar[XB_XGEN(b.x)], 1u);
            asm volatile("s_waitcnt vmcnt(0)" ::: "memory");
        } else {
            XB_SPIN(xb_ld(&bar[XB_XGEN(b.x)]) == gen, bar);
            __builtin_amdgcn_fence(__ATOMIC_ACQUIRE, "agent");
            asm volatile("s_waitcnt vmcnt(0)" ::: "memory");
        }
    }
    __syncthreads();
}


constexpr int RG_XRB = 0, RG_XRF = RG_XRB + 128 * 72 * 2, RG_A = RG_XRF + 128 * 32 * 4, RG_U = RG_A + 128 * 32 * 4, RG_PE = RG_U + 128 * 32 * 4, RG_HIN = RG_PE + 16 * 32 * 2 * 4, RG_CW = RG_HIN + 128,
              RG_GB = RG_CW + 5 * 64 * 4, RG_YSQ = RG_GB + 128 * 32 * 2, RG_END = RG_YSQ + 128 * 33 * 4;
static_assert(RG_END <= 131072 && RG_XRF % 16 == 0 && RG_CW % 16 == 0 && RG_GB % 16 == 0, "rglru lds");
typedef short rg_bf16x8 __attribute__((ext_vector_type(8)));
__device__ __forceinline__ void rglru_unit(LAS unsigned char* lds, int unit, const bf16* PBp, bf16* MGp, float* SSQRp, const float* cw, const float* cbias, const float* wa, const float* ba, const float* wx, const float* bxp, const float* lam) {
    int tid_l = threadIdx.x; asm volatile("" : "+v"(tid_l));
    const int tid = tid_l, lane = tid & 63, wave = __builtin_amdgcn_readfirstlane(tid >> 6), fr = lane & 15, fq = lane >> 4;
    const int b = unit >> 4, g = (unit >> 1) & 7, hf = unit & 1;
    LAS unsigned short* XRB = (LAS unsigned short*)(lds + RG_XRB); LAS float* XRF = (LAS float*)(lds + RG_XRF);
    LAS float* AL = (LAS float*)(lds + RG_A); LAS float* UL = (LAS float*)(lds + RG_U);
    LAS float* PE = (LAS float*)(lds + RG_PE); LAS float* HIN = (LAS float*)(lds + RG_HIN); LAS float* CW = (LAS float*)(lds + RG_CW);
    LAS unsigned short* GBL = (LAS unsigned short*)(lds + RG_GB); LAS float* YSQ = (LAS float*)(lds + RG_YSQ);
    if (tid < 320) { const int k = tid >> 6, c = tid & 63; CW[tid] = (k < 4) ? cw[k * DREC + g * 64 + c] : cbias[g * 64 + c]; }
    if (tid < 32) HIN[tid] = 0.f;
    rg_bf16x8 wb[4][2];
#pragma unroll
    for (int nb = 0; nb < 4; ++nb)
#pragma unroll
        for (int kk = 0; kk < 2; ++kk) { const float* wsrc = ((nb >> 1) ? wx : wa) + ((size_t)g * 64 + 32 * kk + 8 * fq) * 64 + hf * 32 + 16 * (nb & 1) + fr;
            unsigned pk[4];
#pragma unroll
            for (int e = 0; e < 4; ++e) pk[e] = pk2(wsrc[(2 * e) * 64], wsrc[(2 * e + 1) * 64]);
            wb[nb][kk] = __builtin_bit_cast(rg_bf16x8, (v4u){pk[0], pk[1], pk[2], pk[3]}); }
    float gba[2], gbx[2], gsp[2];
#pragma unroll
    for (int cb = 0; cb < 2; ++cb) { const int cj = g * 64 + hf * 32 + 16 * cb + fr; gba[cb] = ba[cj]; gbx[cb] = bxp[cj]; const float lamj = lam[cj];
        gsp[cb] = -8.0f * 1.4426950408889634f * ((lamj > 0.f) ? __logf(1.0f + __expf(-lamj)) : (-lamj + __logf(1.0f + __expf(lamj)))); }
    const int ctt = tid >> 2, ch0 = (tid & 3) * 16;
    const size_t rowb = (size_t)b * SEQ;
    const bf16* xsrc = PBp + 1536 + g * 64 + ch0;
    const bf16* gsrc = PBp + 2048 + g * 64 + hf * 32 + (tid & 3) * 8;
    v4u xv[4][2]; v4u gv;
#define RG_PREFETCH(t0) do { _Pragma("unroll") for (int k = 0; k < 4; ++k) { const int tg = (t0) + ctt - 3 + k; \
        if (tg >= 0) { const bf16* p = xsrc + (rowb + tg) * PPITCH; xv[k][0] = *(const v4u*)p; xv[k][1] = *(const v4u*)(p + 8); } else { xv[k][0] = (v4u){0u, 0u, 0u, 0u}; xv[k][1] = (v4u){0u, 0u, 0u, 0u}; } } \
        gv = *(const v4u*)(gsrc + (rowb + (t0) + ctt) * PPITCH); } while (0)
    RG_PREFETCH(0);
    __syncthreads();
    const int sc = tid & 31, ss = tid >> 5;
#pragma unroll 1
    for (int ck = 0; ck < 16; ++ck) {
        const int t0 = ck * 128;
        {
            unsigned pkx[8];
#pragma unroll
            for (int q4 = 0; q4 < 4; ++q4) {
                f32x4 o = *(const LAS f32x4*)(CW + 4 * 64 + ch0 + q4 * 4);
#pragma unroll
                for (int k = 0; k < 4; ++k) { const f32x4 wv = *(const LAS f32x4*)(CW + k * 64 + ch0 + q4 * 4);
#pragma unroll
                    for (int e = 0; e < 4; ++e) { const int ch = q4 * 4 + e; const unsigned w = ((ch >> 3) ? xv[k][1] : xv[k][0])[(ch & 7) >> 1]; const float x = (ch & 1) ? bfhi(w) : bflo(w); o[e] = fmaf(wv[e], x, o[e]); } }
                pkx[2 * q4] = pk2(o[0], o[1]); pkx[2 * q4 + 1] = pk2(o[2], o[3]);
                if ((ch0 >> 5) == hf) *(LAS f32x4*)(XRF + ctt * 32 + (ch0 & 31) + q4 * 4) = o;
            }
            *(LAS v4u*)(XRB + ctt * 72 + ch0) = (v4u){pkx[0], pkx[1], pkx[2], pkx[3]};
            *(LAS v4u*)(XRB + ctt * 72 + ch0 + 8) = (v4u){pkx[4], pkx[5], pkx[6], pkx[7]};
            *(LAS v4u*)(GBL + ctt * 32 + (tid & 3) * 8) = gv;
        }
        if (ck < 15) RG_PREFETCH(t0 + 128);
        __syncthreads();
        {
            typedef float f32x4m __attribute__((ext_vector_type(4)));
            const rg_bf16x8 a0 = *(const LAS rg_bf16x8*)(XRB + (wave * 16 + fr) * 72 + 8 * fq), a1 = *(const LAS rg_bf16x8*)(XRB + (wave * 16 + fr) * 72 + 32 + 8 * fq);
            f32x4m d[4];
#pragma unroll
            for (int nb = 0; nb < 4; ++nb) { d[nb] = (f32x4m){0.f, 0.f, 0.f, 0.f};
                d[nb] = __builtin_amdgcn_mfma_f32_16x16x32_bf16(a0, wb[nb][0], d[nb], 0, 0, 0); d[nb] = __builtin_amdgcn_mfma_f32_16x16x32_bf16(a1, wb[nb][1], d[nb], 0, 0, 0); }
#pragma unroll
            for (int cb = 0; cb < 2; ++cb)
#pragma unroll
                for (int e = 0; e < 4; ++e) {
                    const int tok = wave * 16 + 4 * fq + e, cl = 16 * cb + fr;
                    const float r = fsigmoid(d[cb][e] + gba[cb]), ig = fsigmoid(d[2 + cb][e] + gbx[cb]);
                    const float a = __builtin_amdgcn_exp2f(r * gsp[cb]);
                    const float om = fmaxf(1.0f - a * a, 0.0f);
                    AL[tok * 32 + cl] = a; UL[tok * 32 + cl] = __builtin_amdgcn_sqrtf(om) * (ig * XRF[tok * 32 + cl]);
                }
        }
        __syncthreads();
        float av[8], uv[8];
#pragma unroll
        for (int k = 0; k < 8; ++k) { av[k] = AL[(ss * 8 + k) * 32 + sc]; uv[k] = UL[(ss * 8 + k) * 32 + sc]; }
        { float h = 0.f, p = 1.f;
#pragma unroll
          for (int k = 0; k < 8; ++k) { h = av[k] * h + uv[k]; p *= av[k]; }
          PE[(ss * 32 + sc) * 2] = p; PE[(ss * 32 + sc) * 2 + 1] = h; }
        __syncthreads();
        float h = HIN[sc];
        { typedef float f32x2v __attribute__((ext_vector_type(2))); f32x2v pe[15];
#pragma unroll
          for (int s2 = 0; s2 < 15; ++s2) pe[s2] = *(const LAS f32x2v*)(PE + (s2 * 32 + sc) * 2);
#pragma unroll
          for (int s2 = 0; s2 < 15; ++s2) h = (s2 < ss) ? fmaf(pe[s2].x, h, pe[s2].y) : h; }
        bf16* orow = MGp + (rowb + t0 + ss * 8) * DM + 512 + g * 64 + hf * 32 + sc;
#pragma unroll
        for (int k = 0; k < 8; ++k) { h = av[k] * h + uv[k]; const float gbf = __uint_as_float((unsigned)GBL[(ss * 8 + k) * 32 + sc] << 16); const unsigned yb = f2bf(h * fgelu_tanh(gbf)); orow[(size_t)k * DM] = (bf16)yb;
            const float yf = __uint_as_float(yb << 16); YSQ[(ss * 8 + k) * 33 + sc] = yf * yf; }
        __syncthreads();
        if (ss == 15) HIN[sc] = h;
        if (tid < 128) { float sq = 0.f;
#pragma unroll
            for (int c2 = 0; c2 < 32; ++c2) sq += YSQ[tid * 33 + c2];
            SSQRp[(rowb + t0 + tid) * 16 + g * 2 + hf] = sq; }
    }
    __syncthreads();
#undef RG_PREFETCH
}

typedef const __attribute__((address_space(4))) Args* KARGS_T;
#define PH_BEGIN int tid_ = threadIdx.x; asm volatile("" : "+v"(tid_)); int ll = l; asm volatile("" : "+s"(ll)); \
    KARGS_T ap = (KARGS_T)__builtin_amdgcn_kernarg_segment_ptr(); asm volatile("" : "+s"(ap)); unsigned char* ws = ap->ws; \
    const int tid = tid_, lane = tid & 63, wave = __builtin_amdgcn_readfirstlane(tid >> 6), gw = bx * NWAVES + wave, gt = bx * NTHR + tid; (void)lane; (void)gw; (void)gt; (void)ll; \
    unsigned mo_ = 131072 + 320 + 13 * 4; asm volatile("" : "+v"(mo_)); const int cx = __builtin_amdgcn_readfirstlane((int)*(volatile LAS unsigned*)(lds + mo_)); __builtin_assume(cx >= 0 && cx < 256); (void)cx;

#define x_in (ap->in[0])
#define X (ap->out)
#define XB ((bf16*)(ws + WS_XB))
#define HB ((bf16*)(ws + WS_HP))
#define PB ((bf16*)(ws + WS_HP))
#define MG ((bf16*)(ws + WS_MG))
#define SSQ ((float*)(ws + WS_SSQ))
#define SSQA ((float*)(ws + WS_A))
#define SSQR ((float*)(ws + WS_A + 2 * MiB))
#define ROPE_C ((float*)(ws + WS_ROPE))
#define ROPE_S (ROPE_C + SEQ * 32)
#define CARRY_P ((float*)(ws + WS_CARRY))
#define CARRY_E (CARRY_P + BATCH * NCHUNK * DREC)
#define Wf1i ((bf16*)(ws + WS_W + (size_t)ll * W_END + W_F1I))
#define Wf1o ((bf16*)(ws + WS_W + (size_t)ll * W_END + W_F1O))
#define Win ((bf16*)(ws + WS_W + (size_t)ll * W_END + W_IN))
#define Wout ((bf16*)(ws + WS_W + (size_t)ll * W_END + W_OUT))
#define Wf2i ((bf16*)(ws + WS_W + (size_t)ll * W_END + W_F2I))
#define Wf2o ((bf16*)(ws + WS_W + (size_t)ll * W_END + W_F2O))
#define LP(idx, stride) (ap->in[idx] + (size_t)ll * (size_t)(stride))
#define f1_norm LP(1, DM)
#define f1_wi LP(2, DM * NFF)
#define f1_wo LP(3, DFF * DM)
#define mix_norm LP(4, DM)
#define w_in LP(5, DM * NPROJ)
#define conv_w LP(6, 4 * DREC)
#define conv_b LP(7, DREC)
#define rg_wa LP(8, 8 * 64 * 64)
#define rg_ba LP(9, DREC)
#define rg_wx LP(10, 8 * 64 * 64)
#define rg_bx LP(11, DREC)
#define rg_lam LP(12, DREC)
#define attn_g LP(13, DATT)
#define rec_g LP(14, DREC)
#define w_out LP(15, DM * DM)
#define f2_norm LP(16, DM)
#define f2_wi LP(17, DM * NFF)
#define f2_wo LP(18, DFF * DM)
#define Xsrc ((ll == 0) ? x_in : (const float*)X)
__global__ void __launch_bounds__(NTHR, 2) hymba_fwd(Args args) {
    extern __shared__ __attribute__((aligned(16))) unsigned char lds_raw[];
    LAS unsigned char* lds = (LAS unsigned char*)lds_raw;
    constexpr int G = 256; const int bx = blockIdx.x; __builtin_assume(bx >= 0 && bx < 256); constexpr int NGW = G * NWAVES, NGT = G * NTHR;
    volatile LAS unsigned* MISC = (volatile LAS unsigned*)(lds + 131072 + 320);
    if (threadIdx.x < 32) MISC[threadIdx.x] = 0u;
    __syncthreads();
    { KARGS_T ap0 = (KARGS_T)__builtin_amdgcn_kernarg_segment_ptr(); unsigned* bar0 = (unsigned*)(ap0->ws + WS_CTL) + 4096; const unsigned xcc0 = xb_xcc_id();
      if (threadIdx.x == 0) { MISC[10] = xb_add(&bar0[XB_XCNT(xcc0)], 1u); MISC[11] = xcc0; MISC[13] = blockIdx.x; } }
    __syncthreads();
#define XB_LOCAL(j) (3520 + 64 * (j))
#define GSYNC() do { KARGS_T apb = (KARGS_T)__builtin_amdgcn_kernarg_segment_ptr(); asm volatile("" : "+s"(apb)); unsigned* bar_ = (unsigned*)(apb->ws + WS_CTL) + 4096; \
    volatile LAS unsigned* M_ = (volatile LAS unsigned*)(lds + 131072 + 320); \
    if (M_[12]) { asm volatile("s_waitcnt vmcnt(0)" ::: "memory"); __syncthreads(); \
        if (threadIdx.x == 0) { const unsigned rd_ = M_[14] + 1u; M_[14] = rd_; unsigned* cnt_ = bar_ + XB_LOCAL(M_[15]); \
            (void)xb_add(cnt_, 1u); XB_SPIN(xb_ld(cnt_) < rd_ * 32u, bar_); \
            __builtin_amdgcn_fence(__ATOMIC_ACQUIRE, "agent"); asm volatile("s_waitcnt vmcnt(0)" ::: "memory"); } \
        __syncthreads(); } \
    else { XcdBarrier b_; b_.bar = bar_; b_.x = xb_xcc_id(); b_.st = M_ + 8; xcd_barrier(b_); } } while (0)
    { const int l = 0; PH_BEGIN
    for (int i = gt; i < SEQ * 32; i += NGT) { const int pos = i >> 5, d = i & 31; const float inv = powf(10000.0f, -(float)(2 * d) / 64.0f); const float ang = (float)pos * inv;
        ROPE_C[i] = cosf(ang); ROPE_S[i] = sinf(ang); }
      for (int m = gw; m < M; m += NGW) {
          const f32x4* xr = (const f32x4*)(x_in + (size_t)m * DM) + lane; f32x4 v[4]; float sq = 0.f;
#pragma unroll
          for (int j = 0; j < 4; ++j) { v[j] = xr[64 * j]; sq += (v[j].x * v[j].x + v[j].y * v[j].y) + (v[j].z * v[j].z + v[j].w * v[j].w); }
          sq = wave_sum(sq);
          unsigned long long* o8 = (unsigned long long*)(XB + (size_t)m * DM) + lane;
#pragma unroll
          for (int j = 0; j < 4; ++j) o8[64 * j] = (unsigned long long)pk2(v[j].x, v[j].y) | ((unsigned long long)pk2(v[j].z, v[j].w) << 32);
          if (lane < 16) SSQ[(size_t)m * 16 + lane] = (lane == 0) ? sq : 0.f;
      } }
    for (int l = 0; l < DEPTH; ++l) {
        { PH_BEGIN
            LAS float* scr = (LAS float*)(lds + wave * 16384);
            constexpr int I_FI = (DM / 64) * (NFF / 32), I_FO = (DFF / 64) * (DM / 32), I_IN = (DM / 64) * (NPROJ / 32), I_OUT = (DM / 64) * (DM / 32);
            constexpr int NIT = 2 * (I_FI + I_FO) + I_IN + I_OUT;
            for (int it = gw; it < NIT; it += NGW) {
                int r = it;
                if (r < I_FI) { transpose_item(f1_wi, DM, NFF, Wf1i, 1, f1_norm, scr, r, lane); continue; } r -= I_FI;
                if (r < I_FO) { transpose_item(f1_wo, DFF, DM, Wf1o, 0, nullptr, scr, r, lane); continue; } r -= I_FO;
                if (r < I_IN) { transpose_item(w_in, DM, NPROJ, Win, 2, mix_norm, scr, r, lane); continue; } r -= I_IN;
                if (r < I_OUT) { const int k0_ = 64 * (r / (DM / 32)); transpose_item(w_out, DM, DM, Wout, 0, (k0_ < 512) ? attn_g : (rec_g - 512), scr, r, lane); continue; } r -= I_OUT;
                if (r < I_FI) { transpose_item(f2_wi, DM, NFF, Wf2i, 1, f2_norm, scr, r, lane); continue; } r -= I_FI;
                transpose_item(f2_wo, DFF, DM, Wf2o, 0, nullptr, scr, r, lane);
            }
        }
    }
    cg::this_grid().sync();
    { KARGS_T ap0 = (KARGS_T)__builtin_amdgcn_kernarg_segment_ptr(); unsigned* bar0 = (unsigned*)(ap0->ws + WS_CTL) + 4096;
      if (threadIdx.x == 0) { unsigned nz = 0u, ok = 1u, gi = 0u; const unsigned x = MISC[11];
#pragma unroll 1
          for (unsigned j = 0; j < 16; ++j) { const unsigned c = xb_ld(&bar0[XB_XCNT(j)]); if (c) { ++nz; if (c != 32u) ok = 0u; if (j < x) ++gi; } }
          ok = (ok && nz == 8u) ? 1u : 0u;
          MISC[12] = ok; MISC[13] = ok ? (MISC[10] * 8u + gi) : (unsigned)blockIdx.x; MISC[14] = 0u; MISC[15] = gi; }
      __syncthreads(); }

    for (int l = 0; l < DEPTH; ++l) {
        { PH_BEGIN pg8::Gemm g{XB, Wf1i, M, NFF, DM}; pg8::RsOrder S; S.init(M, NFF, G, cx); S.ssq = SSQ; S.rsb = (LAS float*)(lds + 131072 + 1024); pg8::EpiSwiGLU E{HB, DFF, S.rsb};
          pg8::gemm_phase<pg8::EpiSwiGLU, pg8::RsOrder, true, true>(lds, g, S, E); }
        GSYNC();
        { PH_BEGIN pg8::Gemm g{HB, Wf1o, M, DM, DFF}; pg8::StaticOrder S; S.init(M, DM, G, cx); pg8::EpiResid2B E{XB, SSQ, DM, 0.5f};
          pg8::gemm_phase<pg8::EpiResid2B, pg8::StaticOrder, true, true>(lds, g, S, E); }
        GSYNC();
        { PH_BEGIN pg8::Gemm g{XB, Win, M, NPROJ, DM}; pg8::RsOrder S; S.init(M, NPROJ, G, cx); S.ssq = SSQ; S.rsb = (LAS float*)(lds + 131072 + 1024); pg8::EpiProj E{PB, PPITCH, S.rsb, ROPE_C, ROPE_S};
          pg8::gemm_phase<pg8::EpiProj, pg8::RsOrder, true, true>(lds, g, S, E); }
        GSYNC();
        { PH_BEGIN
          { const int vcu = (cx % 8) * (G / 8) + cx / 8;
            for (int un = vcu; un < BATCH * 16; un += G) rglru_unit(lds, un, PB, MG, SSQR, conv_w, conv_b, rg_wa, rg_ba, rg_wx, rg_bx, rg_lam); }
          attn_body::build_bias_table((char*)lds_raw);
          const attn_body::AttnTensors AT{(const attn_body::bf16*)PB, (const attn_body::bf16*)(PB + 512), (const attn_body::bf16*)(PB + 1024), (attn_body::bf16*)MG, SSQA};
          const attn_body::StaticOrder S((int)G, (int)cx);
          attn_body::attn_phase<attn_body::StaticOrder>((char*)lds_raw, AT, S); }
        GSYNC();
        { PH_BEGIN pg8::Gemm g{MG, Wout, M, DM, DM}; pg8::MixOrder S; S.init(M, DM, G, cx); S.ssqa = SSQA; S.ssqr = SSQR; S.rsb = (LAS float*)(lds + 131072 + 1024);
          pg8::EpiResidMixB E{XB, SSQ, DM, S.rsb};
          pg8::gemm_phase<pg8::EpiResidMixB, pg8::MixOrder, true, true>(lds, g, S, E); }
        GSYNC();
        { PH_BEGIN pg8::Gemm g{XB, Wf2i, M, NFF, DM}; pg8::RsOrder S; S.init(M, NFF, G, cx); S.ssq = SSQ; S.rsb = (LAS float*)(lds + 131072 + 1024); pg8::EpiSwiGLU E{HB, DFF, S.rsb};
          pg8::gemm_phase<pg8::EpiSwiGLU, pg8::RsOrder, true, true>(lds, g, S, E); }
        GSYNC();
        { PH_BEGIN pg8::Gemm g{HB, Wf2o, M, DM, DFF}; pg8::StaticOrder S; S.init(M, DM, G, cx); pg8::EpiResid2B E{XB, SSQ, DM, 0.5f};
          pg8::gemm_phase<pg8::EpiResid2B, pg8::StaticOrder, true, true>(lds, g, S, E); }
        GSYNC();
    }
    { const int l = 0; PH_BEGIN
        const float* fg = ap->in[19];
        for (int j = 0; j < 16; ++j) { const int m = (cx % 8) * 4096 + ((cx / 8) * 8 + wave) * 16 + j;
            const v4u w0 = *(const v4u*)(XB + (size_t)m * DM + lane * 16), w1 = *(const v4u*)(XB + (size_t)m * DM + lane * 16 + 8);
            const unsigned ww[8] = {w0.x, w0.y, w0.z, w0.w, w1.x, w1.y, w1.z, w1.w};
            float v[16]; float sq = 0.f;
#pragma unroll
            for (int i = 0; i < 8; ++i) { v[2 * i] = bflo(ww[i]); v[2 * i + 1] = bfhi(ww[i]); sq += v[2 * i] * v[2 * i] + v[2 * i + 1] * v[2 * i + 1]; }
            const float r = 1.0f / sqrtf(wave_sum(sq) * (1.0f / DM) + EPS);
            f32x4* op = (f32x4*)(X + (size_t)m * DM + lane * 16); const f32x4* gp = (const f32x4*)(fg + lane * 16);
#pragma unroll
            for (int i = 0; i < 4; ++i) { const f32x4 g4 = gp[i]; op[i] = (f32x4){v[4 * i] * r * g4[0], v[4 * i + 1] * r * g4[1], v[4 * i + 2] * r * g4[2], v[4 * i + 3] * r * g4[3]}; }
        }
    }
}

extern "C" void kernel_launch(void* const* d_in, const int* in_sizes, int n_in, void* d_out, int out_size, void* d_ws, size_t ws_size, hipStream_t stream) {
    static int grid = 0;
    if (grid == 0) {
        if (n_in != 20 || out_size != M * DM || ws_size < WS_END) { fprintf(stderr, "kernel_launch: unexpected shapes (n_in %d out %d ws %zu)\n", n_in, out_size, ws_size); grid = -1; return; }
        int dev = 0, cus = 0, per_cu = 0;
        hipGetDevice(&dev); hipDeviceGetAttribute(&cus, hipDeviceAttributeMultiprocessorCount, dev);
        if (hipFuncSetAttribute((const void*)hymba_fwd, hipFuncAttributeMaxDynamicSharedMemorySize, LDS_BYTES) != hipSuccess) { fprintf(stderr, "hipFuncSetAttribute failed\n"); grid = -1; return; }
        if (hipOccupancyMaxActiveBlocksPerMultiprocessor(&per_cu, (const void*)hymba_fwd, NTHR, LDS_BYTES) != hipSuccess || per_cu < 1) { fprintf(stderr, "occupancy query: %d\n", per_cu); per_cu = 1; }
        (void)hipGetLastError();
        if (cus < 256) { fprintf(stderr, "kernel_launch: built for a 256-CU device (got %d)\n", cus); grid = -1; return; }
        grid = 256;
    }
    if (grid < 0) return;
    if (hipMemsetAsync((char*)d_ws + WS_CTL, 0, 65536, stream) != hipSuccess) { fprintf(stderr, "memset failed\n"); return; }
    Args a{};
    for (int i = 0; i < 20; ++i) a.in[i] = (const float*)d_in[i];
    a.out = (float*)d_out; a.ws = (unsigned char*)d_ws;
    void* kargs[] = {&a};
    hipError_t e = hipLaunchCooperativeKernel((const void*)hymba_fwd, dim3(grid), dim3(NTHR), kargs, LDS_BYTES, stream);
    if (e != hipSuccess) fprintf(stderr, "cooperative launch failed: %s (grid %d)\n", hipGetErrorString(e), grid);
}
```
